# Optimizing an MI355X kernel written in HIP

```python
import jax, jax.numpy as jnp
from jax import lax
import numpy as np

D_MODEL = 2048
BATCH = 2
SEQ = 4096
DEPTH = 4

EXPAND = 2
D_INNER = EXPAND * D_MODEL
PLE_DIM = 256
N_MIXERS = 2
POOL_WINDOWS = (2, 4, 8, 16)
N_POOL_GROUPS = len(POOL_WINDOWS)
POOL_GROUP_DIM = D_INNER // N_POOL_GROUPS
LRU_HEADS = 16
LRU_BLOCK = D_INNER // LRU_HEADS
CONV_WIDTH = 4
LRU_C = 8.0
RMS_EPS = 1e-6
N_POOL_LAYERS = (DEPTH + 1) // 2
N_LRU_LAYERS = DEPTH // 2

kernel_name = "hybrid_pool_rglru_sandwich_ple"


def rmsnorm(x, g):
    xf = x.astype(jnp.float32)
    var = jnp.mean(xf * xf, axis=-1, keepdims=True)
    return (xf * lax.rsqrt(var + RMS_EPS) * g.astype(jnp.float32)).astype(x.dtype)


def pool_mixer(u, w_grp, b, scale):
    B, S, E = u.shape
    maxw = POOL_WINDOWS[-1]
    uf = u.astype(jnp.float32)
    cs = jnp.cumsum(uf, axis=1)
    csp = jnp.pad(cs, ((0, 0), (maxw, 0), (0, 0)))
    pos = jnp.arange(1, S + 1, dtype=jnp.int32)
    diffs = []
    for g, w in enumerate(POOL_WINDOWS):
        c0, c1 = g * POOL_GROUP_DIM, (g + 1) * POOL_GROUP_DIM
        win_sum = csp[:, maxw:, c0:c1] - csp[:, maxw - w:maxw - w + S, c0:c1]
        count = jnp.minimum(pos, w).astype(jnp.float32)[None, :, None]
        diffs.append(win_sum / count - uf[..., c0:c1])
    d = jnp.stack(diffs, axis=2).astype(u.dtype)
    y = jnp.einsum('bsgc,gcd->bsgd', d, w_grp).reshape(B, S, E) + b
    return y * scale


def causal_depthwise_conv(x, w, b):
    S = x.shape[1]
    xp = jnp.pad(x, ((0, 0), (CONV_WIDTH - 1, 0), (0, 0)))
    y = b
    for k in range(CONV_WIDTH):
        y = y + xp[:, k:k + S] * w[k]
    return y


def rglru(x, wa, ba, wx, bx, lam):
    B, S, E = x.shape
    xb = x.reshape(B, S, LRU_HEADS, LRU_BLOCK)
    r = jax.nn.sigmoid((jnp.einsum('bshi,hij->bshj', xb, wa).reshape(B, S, E) + ba).astype(jnp.float32))
    ig = jax.nn.sigmoid((jnp.einsum('bshi,hij->bshj', xb, wx).reshape(B, S, E) + bx).astype(jnp.float32))
    log_a = -LRU_C * r * jax.nn.softplus(-lam.astype(jnp.float32))
    a = jnp.exp(log_a)
    mult = jnp.sqrt(jnp.maximum(-jnp.expm1(2.0 * log_a), 0.0))
    bterm = mult * ig * x.astype(jnp.float32)

    def combine(left, right):
        a1, b1 = left
        a2, b2 = right
        return a1 * a2, a2 * b1 + b2

    _, h = lax.associative_scan(combine, (a, bterm), axis=1)
    return h.astype(x.dtype)


def setup_inputs(seed: int = 0) -> dict:
    key = jax.random.key(seed)
    ks = jax.random.split(key, 24)
    f32 = jnp.float32

    def nrm(k, shape, fan_in):
        return jax.random.normal(k, shape, f32) * (fan_in ** -0.5)

    def gain(k, shape):
        return 1.0 + 0.05 * jax.random.normal(k, shape, f32)

    def bias(k, shape):
        return 0.01 * jax.random.normal(k, shape, f32)

    a0 = jax.random.uniform(ks[15], (N_LRU_LAYERS, D_INNER), f32, 0.9, 0.999)
    lru_L = jnp.log(a0) - jnp.log1p(-a0)
    return {
        "x": jax.random.normal(ks[0], (BATCH, SEQ, D_MODEL), f32),
        "p": jax.random.normal(ks[1], (DEPTH, BATCH, SEQ, PLE_DIM), f32),
        "w_in": nrm(ks[2], (DEPTH, D_MODEL, 2 * D_INNER), D_MODEL),
        "w_out": nrm(ks[3], (DEPTH, D_INNER, D_MODEL), D_INNER),
        "g_pre": gain(ks[4], (DEPTH, D_MODEL)),
        "g_post": gain(ks[5], (DEPTH, D_MODEL)),
        "pool_w": nrm(ks[6], (N_POOL_LAYERS, N_POOL_GROUPS, POOL_GROUP_DIM, POOL_GROUP_DIM), POOL_GROUP_DIM),
        "pool_b": bias(ks[7], (N_POOL_LAYERS, D_INNER)),
        "pool_scale": gain(ks[8], (N_POOL_LAYERS, D_INNER)),
        "conv_w": nrm(ks[9], (N_LRU_LAYERS, CONV_WIDTH, D_INNER), CONV_WIDTH),
        "conv_b": bias(ks[10], (N_LRU_LAYERS, D_INNER)),
        "lru_wa": nrm(ks[11], (N_LRU_LAYERS, LRU_HEADS, LRU_BLOCK, LRU_BLOCK), LRU_BLOCK),
        "lru_ba": bias(ks[12], (N_LRU_LAYERS, D_INNER)),
        "lru_wx": nrm(ks[13], (N_LRU_LAYERS, LRU_HEADS, LRU_BLOCK, LRU_BLOCK), LRU_BLOCK),
        "lru_bx": bias(ks[14], (N_LRU_LAYERS, D_INNER)),
        "lru_L": lru_L,
        "w_ple": nrm(ks[16], (DEPTH, PLE_DIM, D_MODEL), PLE_DIM),
        "w_ple_gate": nrm(ks[17], (DEPTH, D_MODEL, D_MODEL), D_MODEL),
        "g_ple_in": gain(ks[18], (DEPTH, D_MODEL)),
        "g_ple_out": gain(ks[19], (DEPTH, D_MODEL)),
    }


def reference(x, p, w_in, w_out, g_pre, g_post, pool_w, pool_b, pool_scale,
              conv_w, conv_b, lru_wa, lru_ba, lru_wx, lru_bx, lru_L,
              w_ple, w_ple_gate, g_ple_in, g_ple_out):
    for i in range(DEPTH):
        h = rmsnorm(x, g_pre[i])
        uz = jnp.einsum('bsd,de->bse', h, w_in[i])
        u, z = uz[..., :D_INNER], uz[..., D_INNER:]
        j = i // N_MIXERS
        if i % N_MIXERS == 0:
            y = pool_mixer(u, pool_w[j], pool_b[j], pool_scale[j])
        else:
            uc = causal_depthwise_conv(u, conv_w[j], conv_b[j])
            y = rglru(uc, lru_wa[j], lru_ba[j], lru_wx[j], lru_bx[j], lru_L[j])
        y = y * jax.nn.silu(z)
        o = jnp.einsum('bse,ed->bsd', y, w_out[i])
        x = x + rmsnorm(o, g_post[i])
        gate = jax.nn.sigmoid(jnp.einsum('bsd,de->bse', rmsnorm(x, g_ple_in[i]), w_ple_gate[i]))
        e = jnp.einsum('bsk,kd->bsd', p[i], w_ple[i])
        x = x + rmsnorm(e * gate, g_ple_out[i])
    return x
```

```cpp
#include <hip/hip_runtime.h>
#include <hip/hip_cooperative_groups.h>
#include <cstdio>
#include <cstdint>
namespace cg = cooperative_groups;

#ifndef MK_ONE_LAUNCH
#define MK_ONE_LAUNCH 1
#endif

#define LAS __attribute__((address_space(3)))
typedef unsigned short bf16_t;
typedef short bf16x8 __attribute__((ext_vector_type(8)));
typedef float f32x4 __attribute__((ext_vector_type(4)));
typedef float f32x2 __attribute__((ext_vector_type(2)));
typedef unsigned u32x4 __attribute__((ext_vector_type(4)));
typedef unsigned u32x2 __attribute__((ext_vector_type(2)));
typedef _Float16 f16x2 __attribute__((ext_vector_type(2)));

constexpr int M = 8192, DM = 2048, EI = 4096, E2 = 8192, PLE = 256, SEQ = 4096, DEPTH = 4;
constexpr float RMS_EPS = 1e-6f;
constexpr float LOG2E = 1.4426950408889634f;

constexpr size_t MiB = 1u << 20;
constexpr size_t WS_WIN = 16 * MiB;
constexpr size_t WS_WOUT = 144 * MiB;
constexpr size_t WS_WG = 208 * MiB;
constexpr size_t WS_POOL = 240 * MiB;
constexpr size_t WS_WPLE = 256 * MiB;
constexpr size_t WS_LRU = 260 * MiB;
constexpr size_t WS_H = 272 * MiB;
constexpr size_t WS_UZ = 304 * MiB;
constexpr size_t WS_D = 432 * MiB;
constexpr size_t WS_Y = 496 * MiB;
constexpr size_t WS_O = 560 * MiB;
constexpr size_t WS_E = 624 * MiB;
constexpr size_t WS_LA = 656 * MiB;
constexpr size_t WS_BT = 720 * MiB;
constexpr size_t WS_SP = 784 * MiB;
constexpr size_t WS_SH = 788 * MiB;
constexpr size_t WS_P16 = 792 * MiB;
constexpr size_t WS_NSP = 808 * MiB;
constexpr size_t WS_DBG = 809 * MiB;
constexpr size_t WS_END = 810 * MiB;

constexpr int LDS_BYTES = 147456;

__device__ __forceinline__ unsigned cvt_pk_bf16(float lo, float hi) { unsigned r; asm volatile("v_cvt_pk_bf16_f32 %0, %1, %2" : "=v"(r) : "v"(lo), "v"(hi)); return r; }
__device__ __forceinline__ float bf_lo(unsigned w) { return __uint_as_float(w << 16); }
__device__ __forceinline__ float bf_hi(unsigned w) { return __uint_as_float(w & 0xffff0000u); }
__device__ __forceinline__ unsigned pk_f16(float a, float b) { f16x2 h; h.x = (_Float16)a; h.y = (_Float16)b; return __builtin_bit_cast(unsigned, h); }
__device__ __forceinline__ float f16_lo(unsigned w) { f16x2 h = __builtin_bit_cast(f16x2, w); return (float)h.x; }
__device__ __forceinline__ float f16_hi(unsigned w) { f16x2 h = __builtin_bit_cast(f16x2, w); return (float)h.y; }
__device__ __forceinline__ float sigmoidf_fast(float v) { return __builtin_amdgcn_rcpf(1.0f + __builtin_amdgcn_exp2f(-v * LOG2E)); }
__device__ __forceinline__ float wave_sum(float v) {
#pragma unroll
    for (int o = 1; o < 64; o <<= 1) v += __shfl_xor(v, o);
    return v;
}

namespace pg8 {
constexpr int BM = 256, BK = 64, HALF = 128, HTB = HALF * BK * 2, STAGE_BYTES = 8 * HTB, NXCD = 8, WGM = 8;
__host__ __device__ __forceinline__ int lds_byte(int r, int c) { const int st = (r >> 4) * 2 + (c >> 5), rr = r & 15, cc = c & 31, ob = rr * 64 + cc * 2; return st * 1024 + (ob ^ (((ob >> 9) & 1) << 5)); }
__host__ __device__ __forceinline__ void stage_rc(int b, int& R, int& C) { const int st = b / 1024, sb = b % 1024, swz = sb ^ (((sb >> 9) & 1) << 5); R = (st >> 1) * 16 + swz / 64; C = (st & 1) * 32 + (swz % 64) / 2; }
__host__ __device__ __forceinline__ int perm32(int rho) { const int n = rho >> 4, i = rho & 15; return 8 * (i >> 2) + 4 * n + (i & 3); }

struct Unit { int pm, pn; };
struct Gemm { const bf16_t* A; const bf16_t* Bt; };

template <int nM, int nN> struct StaticOrder {
    int G, c;
    static constexpr int nwg = nM * nN;
    __device__ __forceinline__ void init(int G_, int c_) { G = G_; c = c_; }
    __device__ __forceinline__ bool next(int i, Unit& u) const {
        const int L = i * G + c; if (L >= nwg) return false;
        int wgid = L; { constexpr int q = nwg / NXCD, r = nwg % NXCD; const int xcd = wgid % NXCD, off = wgid / NXCD; wgid = (xcd < r ? xcd * (q + 1) : r * (q + 1) + (xcd - r) * q) + off; }
        constexpr int nig = WGM * nN; const int gid = wgid / nig, fm = gid * WGM, gsz = (nM - fm) < WGM ? (nM - fm) : WGM;
        u.pm = fm + ((wgid % nig) % gsz); u.pn = (wgid % nig) / gsz; return true;
    }
};

struct EpiF32 {
    static constexpr bool PERM = false;
    float* C; int ldc;
    __device__ __forceinline__ void operator()(const f32x4 (&acc)[2][2][4][2], const Unit& u, int wr, int wc, int fr, int fq) const {
        const int row0 = u.pm * BM + wr * 64 + fr, col0 = u.pn * BM + wc * 32 + 4 * fq;
#pragma unroll
        for (int ai = 0; ai < 2; ++ai)
#pragma unroll
            for (int m = 0; m < 4; ++m) { float* rowp = C + (size_t)(row0 + ai * HALF + m * 16) * ldc + col0;
#pragma unroll
                for (int bj = 0; bj < 2; ++bj)
#pragma unroll
                    for (int n = 0; n < 2; ++n) *(f32x4*)(rowp + bj * HALF + n * 16) = acc[ai][bj][m][n]; }
    }
};
struct EpiBf16 {
    static constexpr bool PERM = true;
    bf16_t* O; int ldc;
    __device__ __forceinline__ void operator()(const f32x4 (&acc)[2][2][4][2], const Unit& u, int wr, int wc, int fr, int fq) const {
        const int row0 = u.pm * BM + wr * 64 + fr, col0 = u.pn * BM + wc * 32 + 8 * fq;
#pragma unroll
        for (int ai = 0; ai < 2; ++ai)
#pragma unroll
            for (int m = 0; m < 4; ++m) { bf16_t* rowp = O + (size_t)(row0 + ai * HALF + m * 16) * ldc + col0;
#pragma unroll
                for (int bj = 0; bj < 2; ++bj) { const f32x4 v0 = acc[ai][bj][m][0], v1 = acc[ai][bj][m][1];
                    u32x4 w; w.x = cvt_pk_bf16(v0[0], v0[1]); w.y = cvt_pk_bf16(v0[2], v0[3]); w.z = cvt_pk_bf16(v1[0], v1[1]); w.w = cvt_pk_bf16(v1[2], v1[3]);
                    *(u32x4*)(rowp + bj * HALF) = w; } }
    }
};
struct EpiPool {
    static constexpr bool PERM = true;
    bf16_t* Y; const bf16_t* UZ; const float* pb; const float* ps;
    __device__ __forceinline__ void operator()(const f32x4 (&acc)[2][2][4][2], const Unit& u, int wr, int wc, int fr, int fq) const {
        const int row0 = u.pm * BM + wr * 64 + fr, col0 = u.pn * BM + wc * 32 + 8 * fq;
#pragma unroll
        for (int bj = 0; bj < 2; ++bj) {
            const int c = col0 + bj * HALF;
            const f32x4 b0 = *(const f32x4*)(pb + c), b1 = *(const f32x4*)(pb + c + 4), s0 = *(const f32x4*)(ps + c), s1 = *(const f32x4*)(ps + c + 4);
#pragma unroll
            for (int ai = 0; ai < 2; ++ai)
#pragma unroll
                for (int m = 0; m < 4; ++m) { const size_t row = (size_t)(row0 + ai * HALF + m * 16);
                    const u32x4 zz = *(const u32x4*)(UZ + row * E2 + EI + c);
                    f32x4 v0 = (acc[ai][bj][m][0] + b0) * s0, v1 = (acc[ai][bj][m][1] + b1) * s1;
                    float z[8] = {bf_lo(zz.x), bf_hi(zz.x), bf_lo(zz.y), bf_hi(zz.y), bf_lo(zz.z), bf_hi(zz.z), bf_lo(zz.w), bf_hi(zz.w)};
#pragma unroll
                    for (int k = 0; k < 4; ++k) { v0[k] *= z[k] * sigmoidf_fast(z[k]); v1[k] *= z[4 + k] * sigmoidf_fast(z[4 + k]); }
                    u32x4 w; w.x = cvt_pk_bf16(v0[0], v0[1]); w.y = cvt_pk_bf16(v0[2], v0[3]); w.z = cvt_pk_bf16(v1[0], v1[1]); w.w = cvt_pk_bf16(v1[2], v1[3]);
                    *(u32x4*)(Y + row * EI + c) = w; }
        }
    }
};
struct EpiLru {
    static constexpr bool PERM = true;
    const bf16_t* UC; unsigned short* LA; bf16_t* BT; const float* ba; const float* bx; const float* lam;
    __device__ __forceinline__ void operator()(const f32x4 (&acc)[2][2][4][2], const Unit& u, int wr, int wc, int fr, int fq) const {
        const int row0 = u.pm * BM + wr * 64 + fr, c = (u.pn >> 1) * 256 + (u.pn & 1) * 128 + wc * 32 + 8 * fq;
        float cba[8], cbx[8], nsp[8];
#pragma unroll
        for (int k = 0; k < 8; ++k) { cba[k] = ba[c + k]; cbx[k] = bx[c + k]; nsp[k] = lam[c + k]; }
#pragma unroll
        for (int ai = 0; ai < 2; ++ai)
#pragma unroll
            for (int m = 0; m < 4; ++m) { const size_t off = (size_t)(row0 + ai * HALF + m * 16) * EI + c;
                const u32x4 uu = *(const u32x4*)(UC + off);
                const float ucv[8] = {bf_lo(uu.x), bf_hi(uu.x), bf_lo(uu.y), bf_hi(uu.y), bf_lo(uu.z), bf_hi(uu.z), bf_lo(uu.w), bf_hi(uu.w)};
                float l2[8], bb[8];
#pragma unroll
                for (int n = 0; n < 2; ++n)
#pragma unroll
                    for (int j = 0; j < 4; ++j) { const int k = 4 * n + j;
                        const float rg = sigmoidf_fast(acc[ai][0][m][n][j] + cba[k]), ig = sigmoidf_fast(acc[ai][1][m][n][j] + cbx[k]);
                        const float l2a = rg * nsp[k]; const float a2 = __builtin_amdgcn_exp2f(2.0f * l2a);
                        const float mult = __builtin_sqrtf(fmaxf(1.0f - a2, 0.f));
                        l2[k] = l2a; bb[k] = mult * ig * ucv[k]; }
                u32x4 wl, wb;
                wl.x = pk_f16(l2[0], l2[1]); wl.y = pk_f16(l2[2], l2[3]); wl.z = pk_f16(l2[4], l2[5]); wl.w = pk_f16(l2[6], l2[7]);
                wb.x = cvt_pk_bf16(bb[0], bb[1]); wb.y = cvt_pk_bf16(bb[2], bb[3]); wb.z = cvt_pk_bf16(bb[4], bb[5]); wb.w = cvt_pk_bf16(bb[6], bb[7]);
                *(u32x4*)(LA + off) = wl; *(u32x4*)(BT + off) = wb;
                asm volatile("" ::: "memory"); }
    }
};
struct EpiGate {
    static constexpr bool PERM = false;
    float* T; const bf16_t* Eb;
    __device__ __forceinline__ void operator()(const f32x4 (&acc)[2][2][4][2], const Unit& u, int wr, int wc, int fr, int fq) const {
        const int row0 = u.pm * BM + wr * 64 + fr, col0 = u.pn * BM + wc * 32 + 4 * fq;
#pragma unroll
        for (int ai = 0; ai < 2; ++ai)
#pragma unroll
            for (int m = 0; m < 4; ++m) { const size_t off = (size_t)(row0 + ai * HALF + m * 16) * DM + col0;
#pragma unroll
                for (int bj = 0; bj < 2; ++bj)
#pragma unroll
                    for (int n = 0; n < 2; ++n) { const u32x2 ee = *(const u32x2*)(Eb + off + bj * HALF + n * 16); const f32x4 a = acc[ai][bj][m][n];
                        f32x4 t; t[0] = bf_lo(ee.x) * sigmoidf_fast(a[0]); t[1] = bf_hi(ee.x) * sigmoidf_fast(a[1]); t[2] = bf_lo(ee.y) * sigmoidf_fast(a[2]); t[3] = bf_hi(ee.y) * sigmoidf_fast(a[3]);
                        *(f32x4*)(T + off + bj * HALF + n * 16) = t; } }
    }
};

template <class Epi, bool ALIGN_EPI, int LDA, int LDB, int K, int GRP, int NM, int NN>
__device__ __forceinline__ void gemm_phase(LAS unsigned char* lds, const Gemm g, const Epi& E, const int tid, const int G, const int bx) {
    StaticOrder<NM, NN> S; S.init(G, bx);
    const int wid = __builtin_amdgcn_readfirstlane(tid >> 6), lane = tid & 63, wr = wid >> 2, wc = wid & 3, fr = lane & 15, fq = lane >> 4;
    constexpr int nt = K / BK;
    unsigned voffA[2], voffB[2];
#pragma unroll
    for (int i = 0; i < 2; ++i) { int R, C; stage_rc(tid * 16 + i * 8192, R, C); const int Rb = Epi::PERM ? ((R & ~31) + perm32(R & 31)) : R;
        voffA[i] = (unsigned)(R * LDA + C) * 2u; voffB[i] = (unsigned)(Rb * LDB + C) * 2u; }
    constexpr size_t kstep = (size_t)(BK * 2);
    constexpr size_t hstepA = (size_t)HALF * LDA * 2, hstepB = (size_t)HALF * LDB * 2;
    const unsigned ldsw = (unsigned)wid * 1024u;
    const int aoff = lds_byte(wr * 64 + fr, fq * 8), boff = lds_byte(wc * 32 + fr, fq * 8);
#define PG8_UA(u) ((const char*)g.A + (size_t)(u).pm * 2 * hstepA + (GRP ? (size_t)((u).pn / (GRP ? GRP : 1)) * K * 2 : (size_t)0))
#define PG8_UB(u) ((const char*)g.Bt + (size_t)(u).pn * 2 * hstepB)
#define PG8_SA(b, h) (((b) * 2 + (h)) * HTB)
#define PG8_SB(b, h) ((4 + (b) * 2 + (h)) * HTB)
#define PG8_STAGE(bufoff, gbase, voff) do { _Pragma("unroll") for (int _i = 0; _i < 2; ++_i) \
        __builtin_amdgcn_global_load_lds((const unsigned*)((const char*)(gbase) + (voff)[_i]), (LAS unsigned*)(lds + (bufoff) + ldsw + _i * 8192), 16, 0, 0); } while (0)
#define PG8_LDA(dst, b, h) do { _Pragma("unroll") for (int m = 0; m < 4; ++m) _Pragma("unroll") for (int k = 0; k < 2; ++k) dst[m][k] = *(const LAS bf16x8*)(lds + PG8_SA(b, h) + aoff + m * 2048 + k * 1024); } while (0)
#define PG8_LDB(dst, b, h) do { _Pragma("unroll") for (int n = 0; n < 2; ++n) _Pragma("unroll") for (int k = 0; k < 2; ++k) dst[n][k] = *(const LAS bf16x8*)(lds + PG8_SB(b, h) + boff + n * 2048 + k * 1024); } while (0)
#define PG8_MMA(ai, bj, At, Bt) do { __builtin_amdgcn_s_setprio(1); _Pragma("unroll") for (int m = 0; m < 4; ++m) _Pragma("unroll") for (int n = 0; n < 2; ++n) _Pragma("unroll") for (int k = 0; k < 2; ++k) \
        acc[ai][bj][m][n] = __builtin_amdgcn_mfma_f32_16x16x32_bf16(Bt[n][k], At[m][k], acc[ai][bj][m][n], 0, 0, 0); __builtin_amdgcn_s_setprio(0); } while (0)
#define PG8_WAIT_V(n) asm volatile("s_waitcnt vmcnt(" #n ")" ::: "memory")
#define PG8_WAIT_L(n) asm volatile("s_waitcnt lgkmcnt(" #n ")" ::: "memory")
#define PG8_BAR __builtin_amdgcn_s_barrier()
#define PG8_SCHED __builtin_amdgcn_sched_barrier(0)
    Unit cur, nxt; int ui = 0;
    if (!S.next(0, cur)) return;
    f32x4 acc[2][2][4][2];
#pragma unroll
    for (int a = 0; a < 2; ++a)
#pragma unroll
        for (int b = 0; b < 2; ++b)
#pragma unroll
            for (int m = 0; m < 4; ++m)
#pragma unroll
                for (int n = 0; n < 2; ++n) acc[a][b][m][n] = (f32x4){0.f, 0.f, 0.f, 0.f};
    bf16x8 At[4][2], B0[2][2], B1[2][2];
    const char* cA = PG8_UA(cur); const char* cB = PG8_UB(cur);
    PG8_STAGE(PG8_SB(0, 0), cB, voffB); PG8_STAGE(PG8_SB(0, 1), cB + hstepB, voffB); PG8_STAGE(PG8_SA(0, 0), cA, voffA); PG8_STAGE(PG8_SA(0, 1), cA + hstepA, voffA);
    if (wr == 1) PG8_BAR;
    PG8_WAIT_V(2); PG8_BAR;
    PG8_STAGE(PG8_SB(1, 0), cB + kstep, voffB); PG8_STAGE(PG8_SA(1, 0), cA + kstep, voffA); PG8_STAGE(PG8_SB(1, 1), cB + hstepB + kstep, voffB);
    PG8_WAIT_V(6); PG8_BAR;
    for (;;) {
        const bool has_next = S.next(ui + 1, nxt);
        const char* nA = has_next ? PG8_UA(nxt) : cA; const char* nB = has_next ? PG8_UB(nxt) : cB;
#pragma nounroll
        for (int t = 0; t < nt; t += 2) {
            const bool last = (t == nt - 2);
            const char* a1 = cA + (size_t)(t + 1) * kstep;
            const char* a2 = last ? nA : cA + (size_t)(t + 2) * kstep; const char* b2 = last ? nB : cB + (size_t)(t + 2) * kstep;
            const char* a3 = a2 + kstep; const char* b3 = b2 + kstep;
            PG8_LDB(B0, 0, 0); PG8_LDB(B1, 0, 1); PG8_SCHED; PG8_LDA(At, 0, 0); PG8_STAGE(PG8_SA(1, 1), a1 + hstepA, voffA);
            PG8_WAIT_V(8); PG8_WAIT_L(0); PG8_BAR; PG8_MMA(0, 0, At, B0); PG8_MMA(0, 1, At, B1); PG8_BAR; PG8_SCHED;
            PG8_LDA(At, 0, 1); PG8_STAGE(PG8_SB(0, 0), b2, voffB); PG8_STAGE(PG8_SB(0, 1), b2 + hstepB, voffB); PG8_STAGE(PG8_SA(0, 0), a2, voffA);
            PG8_WAIT_V(8); PG8_WAIT_L(0); PG8_BAR; PG8_MMA(1, 0, At, B0); PG8_MMA(1, 1, At, B1); PG8_BAR; PG8_SCHED;
            PG8_LDB(B0, 1, 0); PG8_LDB(B1, 1, 1); PG8_SCHED; PG8_LDA(At, 1, 0); PG8_STAGE(PG8_SA(0, 1), a2 + hstepA, voffA);
            PG8_WAIT_V(8); PG8_WAIT_L(0); PG8_BAR; PG8_MMA(0, 0, At, B0); PG8_MMA(0, 1, At, B1); PG8_BAR; PG8_SCHED;
            PG8_LDA(At, 1, 1); PG8_STAGE(PG8_SB(1, 0), b3, voffB); PG8_STAGE(PG8_SB(1, 1), b3 + hstepB, voffB); PG8_STAGE(PG8_SA(1, 0), a3, voffA);
            PG8_WAIT_V(8); PG8_WAIT_L(0); PG8_BAR; PG8_MMA(1, 0, At, B0); PG8_MMA(1, 1, At, B1); PG8_BAR; PG8_SCHED;
        }
        if constexpr (ALIGN_EPI) { if (wr == 0) PG8_BAR; }
        E(acc, cur, wr, wc, fr, fq);
        if (!has_next) break;
#pragma unroll
        for (int a = 0; a < 2; ++a)
#pragma unroll
            for (int b = 0; b < 2; ++b)
#pragma unroll
                for (int m = 0; m < 4; ++m)
#pragma unroll
                    for (int n = 0; n < 2; ++n) acc[a][b][m][n] = (f32x4){0.f, 0.f, 0.f, 0.f};
        cur = nxt; cA = nA; cB = nB; ++ui;
        if constexpr (ALIGN_EPI) { if (wr == 1) PG8_BAR; }
    }
    PG8_WAIT_V(0);
    if constexpr (!ALIGN_EPI) { if (wr == 0) PG8_BAR; }
    PG8_BAR;
#undef PG8_UA
#undef PG8_UB
#undef PG8_SA
#undef PG8_SB
#undef PG8_STAGE
#undef PG8_LDA
#undef PG8_LDB
#undef PG8_MMA
#undef PG8_WAIT_V
#undef PG8_WAIT_L
#undef PG8_BAR
#undef PG8_SCHED
}
}

__device__ __forceinline__ void transpose_item(const float* W, int K, int N, bf16_t* WT, int drow0, int k0, int n0, LAS float* scr, int lane) {
    f32x4 v[8];
    const int lr = lane >> 3, lc = (lane & 7) * 4;
#pragma unroll
    for (int i = 0; i < 8; ++i) v[i] = *(const f32x4*)(W + (size_t)(k0 + 8 * i + lr) * N + n0 + lc);
#pragma unroll
    for (int i = 0; i < 8; ++i) { LAS float* s = scr + (8 * i + lr) * 33 + lc; s[0] = v[i][0]; s[1] = v[i][1]; s[2] = v[i][2]; s[3] = v[i][3]; }
    asm volatile("s_waitcnt lgkmcnt(0)" ::: "memory");
    const int c = lane & 7;
#pragma unroll
    for (int j = 0; j < 4; ++j) { const int n = (lane >> 3) + 8 * j; const LAS float* s = scr + (8 * c) * 33 + n;
        u32x4 o; o.x = cvt_pk_bf16(s[0 * 33], s[1 * 33]); o.y = cvt_pk_bf16(s[2 * 33], s[3 * 33]); o.z = cvt_pk_bf16(s[4 * 33], s[5 * 33]); o.w = cvt_pk_bf16(s[6 * 33], s[7 * 33]);
        *(u32x4*)(WT + (size_t)(drow0 + n) * K + k0 + 8 * c) = o; }
    asm volatile("s_waitcnt lgkmcnt(0)" ::: "memory");
}
__device__ __forceinline__ void transpose_plain(const float* W, int K, int N, bf16_t* WT, int it, LAS float* scr, int lane) {
    const int nblk = N / 32, kb = it / nblk, nb = it % nblk;
    transpose_item(W, K, N, WT, 32 * nb, 64 * kb, 32 * nb, scr, lane);
}
__device__ __forceinline__ void norm_row(const float* xrow, const float* g, bf16_t* hrow, int lane) {
    f32x4 v[8]; float ss = 0.f;
#pragma unroll
    for (int j = 0; j < 8; ++j) { v[j] = *(const f32x4*)(xrow + 4 * lane + 256 * j); ss += (v[j][0] * v[j][0] + v[j][1] * v[j][1]) + (v[j][2] * v[j][2] + v[j][3] * v[j][3]); }
    const float r = 1.0f / sqrtf(wave_sum(ss) * (1.0f / DM) + RMS_EPS);
#pragma unroll
    for (int j = 0; j < 8; ++j) { const f32x4 gg = *(const f32x4*)(g + 4 * lane + 256 * j); const f32x4 h = v[j] * r * gg;
        u32x2 w; w.x = cvt_pk_bf16(h[0], h[1]); w.y = cvt_pk_bf16(h[2], h[3]); *(u32x2*)(hrow + 4 * lane + 256 * j) = w; }
}
__device__ __forceinline__ void res_norm_row(const float* xin, float* xout, const float* o, const float* ga, const float* gb, bf16_t* hrow, bool write_h, int lane) {
    f32x4 v[8], x[8]; float ss = 0.f;
#pragma unroll
    for (int j = 0; j < 8; ++j) { v[j] = *(const f32x4*)(o + 4 * lane + 256 * j); x[j] = *(const f32x4*)(xin + 4 * lane + 256 * j); ss += (v[j][0] * v[j][0] + v[j][1] * v[j][1]) + (v[j][2] * v[j][2] + v[j][3] * v[j][3]); }
    const float r = 1.0f / sqrtf(wave_sum(ss) * (1.0f / DM) + RMS_EPS);
    float s2 = 0.f;
#pragma unroll
    for (int j = 0; j < 8; ++j) { const f32x4 gg = *(const f32x4*)(ga + 4 * lane + 256 * j); x[j] = x[j] + v[j] * r * gg; *(f32x4*)(xout + 4 * lane + 256 * j) = x[j];
        s2 += (x[j][0] * x[j][0] + x[j][1] * x[j][1]) + (x[j][2] * x[j][2] + x[j][3] * x[j][3]); }
    if (write_h) {
        const float r2 = 1.0f / sqrtf(wave_sum(s2) * (1.0f / DM) + RMS_EPS);
#pragma unroll
        for (int j = 0; j < 8; ++j) { const f32x4 gg = *(const f32x4*)(gb + 4 * lane + 256 * j); const f32x4 h = x[j] * r2 * gg;
            u32x2 w; w.x = cvt_pk_bf16(h[0], h[1]); w.y = cvt_pk_bf16(h[2], h[3]); *(u32x2*)(hrow + 4 * lane + 256 * j) = w; }
    }
}
__device__ __forceinline__ void unpack8(const u32x4 w, float (&f)[8]) { f[0] = bf_lo(w.x); f[1] = bf_hi(w.x); f[2] = bf_lo(w.y); f[3] = bf_hi(w.y); f[4] = bf_lo(w.z); f[5] = bf_hi(w.z); f[6] = bf_lo(w.w); f[7] = bf_hi(w.w); }
__device__ __forceinline__ u32x4 pack8(const float (&f)[8]) { u32x4 w; w.x = cvt_pk_bf16(f[0], f[1]); w.y = cvt_pk_bf16(f[2], f[3]); w.z = cvt_pk_bf16(f[4], f[5]); w.w = cvt_pk_bf16(f[6], f[7]); return w; }


#ifndef MK_DEBUG
#define MK_DEBUG 0
#endif
#if MK_DEBUG
__device__ __forceinline__ float dbf(const bf16_t* p, size_t i) { return __uint_as_float(((unsigned)p[i]) << 16); }
__device__ __forceinline__ float dsig(float v) { return 1.0f / (1.0f + expf(-v)); }
__device__ __forceinline__ void dbg_flag(unsigned* fw, int id, float got, float ref, float rtol, float atol) {
    const float err = fabsf(got - ref); if (!(err <= rtol * fabsf(ref) + atol)) atomicMin(fw, (unsigned)id);
}
#endif

struct Args { const float* in[20]; float* out; unsigned char* ws; int ph_lo, ph_hi; };
enum { I_X = 0, I_P, I_WIN, I_WOUT, I_GPRE, I_GPOST, I_POOLW, I_POOLB, I_POOLS, I_CONVW, I_CONVB, I_WA, I_BA, I_WX, I_BX, I_LAM, I_WPLE, I_WG, I_GPIN, I_GPOUT };
constexpr int NPHASE = 1 + DEPTH * 9;

__global__ void __launch_bounds__(512, 2) fwd_megakernel(Args a) {
    extern __shared__ __attribute__((aligned(16))) unsigned char lds_raw[];
    LAS unsigned char* lds = (LAS unsigned char*)lds_raw;
    const int G = gridDim.x;
    typedef const __attribute__((address_space(4))) Args* KArgs;
    KArgs ap = (KArgs)__builtin_amdgcn_kernarg_segment_ptr();
    const int ph_lo = ap->ph_lo, ph_hi = ap->ph_hi;

    for (int ph = ph_lo; ph < ph_hi; ++ph) {
        bool did = true;
        KArgs aq = ap; asm volatile("" : "+s"(aq));
#define a (*aq)
#define PHASE_ROOTS int tid = threadIdx.x, bx = blockIdx.x; asm volatile("" : "+v"(tid)); asm volatile("" : "+s"(bx)); __builtin_assume(tid >= 0 && tid < 512); __builtin_assume(bx >= 0 && bx < 1024); \
        const int lane = tid & 63, wave = __builtin_amdgcn_readfirstlane(tid >> 6); const int gw = bx * 8 + wave, NGW = G * 8; (void)lane; (void)gw; (void)NGW
        unsigned char* ws = a.ws;
        bf16_t* WinT = (bf16_t*)(ws + WS_WIN); bf16_t* WoutT = (bf16_t*)(ws + WS_WOUT); bf16_t* WgT = (bf16_t*)(ws + WS_WG); bf16_t* PoolT = (bf16_t*)(ws + WS_POOL);
        bf16_t* WpleT = (bf16_t*)(ws + WS_WPLE); bf16_t* LruT = (bf16_t*)(ws + WS_LRU);
        bf16_t* H = (bf16_t*)(ws + WS_H); bf16_t* UZ = (bf16_t*)(ws + WS_UZ); bf16_t* Db = (bf16_t*)(ws + WS_D); bf16_t* Y = (bf16_t*)(ws + WS_Y);
        float* O = (float*)(ws + WS_O); bf16_t* Eb = (bf16_t*)(ws + WS_E); unsigned short* LA = (unsigned short*)(ws + WS_LA); bf16_t* BT = (bf16_t*)(ws + WS_BT);
        float* SP = (float*)(ws + WS_SP); float* SH = (float*)(ws + WS_SH); bf16_t* P16 = (bf16_t*)(ws + WS_P16); float* NSP = (float*)(ws + WS_NSP);
        float* X = a.out;

        if (ph == 0) {
            PHASE_ROOTS;
            LAS float* scr = (LAS float*)(lds + wave * 16384);
            constexpr int N_WIN = 4 * 8192, N_WOUT = 4 * 4096, N_WG = 4 * 2048, N_POOL = 8 * 512, N_WPLE = 4 * 256, N_LRU = 64 * 32;
            constexpr int NITEMS = N_WIN + N_WOUT + N_WG + N_POOL + N_WPLE + N_LRU;
            for (int it = gw; it < NITEMS; it += NGW) {
                int r = it;
                if (r < N_WIN) { const int l = r / 8192; transpose_plain(a.in[I_WIN] + (size_t)l * DM * E2, DM, E2, WinT + (size_t)l * E2 * DM, r % 8192, scr, lane); continue; } r -= N_WIN;
                if (r < N_WOUT) { const int l = r / 4096; transpose_plain(a.in[I_WOUT] + (size_t)l * EI * DM, EI, DM, WoutT + (size_t)l * DM * EI, r % 4096, scr, lane); continue; } r -= N_WOUT;
                if (r < N_WG) { const int l = r / 2048; transpose_plain(a.in[I_WG] + (size_t)l * DM * DM, DM, DM, WgT + (size_t)l * DM * DM, r % 2048, scr, lane); continue; } r -= N_WG;
                if (r < N_POOL) { const int q = r / 512; transpose_plain(a.in[I_POOLW] + (size_t)q * 1024 * 1024, 1024, 1024, PoolT + (size_t)q * 1024 * 1024, r % 512, scr, lane); continue; } r -= N_POOL;
                if (r < N_WPLE) { const int l = r / 256; transpose_plain(a.in[I_WPLE] + (size_t)l * PLE * DM, PLE, DM, WpleT + (size_t)l * DM * PLE, r % 256, scr, lane); continue; } r -= N_WPLE;
                { const int q = r / 32, i2 = r % 32, which = q / 32, rem = q % 32, j = rem / 16, h = rem % 16, kb = i2 / 8, nb = i2 % 8, n0 = 32 * nb;
                  const float* src = (which ? a.in[I_WX] : a.in[I_WA]) + (size_t)rem * 65536;
                  const int drow0 = (2 * h + (n0 >> 7)) * 256 + which * 128 + (n0 & 127);
                  transpose_item(src, 256, 256, LruT + (size_t)j * E2 * 256, drow0, 64 * kb, n0, scr, lane); }
            }
            { const size_t n8 = (size_t)DEPTH * M * PLE / 8; const float* p = a.in[I_P];
              for (size_t i = (size_t)bx * 512 + tid; i < n8; i += (size_t)G * 512) { const f32x4 v0 = *(const f32x4*)(p + 8 * i), v1 = *(const f32x4*)(p + 8 * i + 4);
                  u32x4 w; w.x = cvt_pk_bf16(v0[0], v0[1]); w.y = cvt_pk_bf16(v0[2], v0[3]); w.z = cvt_pk_bf16(v1[0], v1[1]); w.w = cvt_pk_bf16(v1[2], v1[3]); *(u32x4*)(P16 + 8 * i) = w; } }
            for (int i = bx * 512 + tid; i < 2 * EI; i += G * 512) { const float nl = -a.in[I_LAM][i]; const float sp = fmaxf(nl, 0.f) + log1pf(expf(-fabsf(nl))); NSP[i] = -8.0f * LOG2E * sp; }
            for (int m = gw; m < M; m += NGW) norm_row(a.in[I_X] + (size_t)m * DM, a.in[I_GPRE], H + (size_t)m * DM, lane);
        } else if (ph < 1 + DEPTH * 9) {
            const int l = (ph - 1) / 9, s = (ph - 1) % 9; const bool lru = (l & 1) != 0; const int j = l >> 1;
            if (s == 0) {
                PHASE_ROOTS;
                pg8::Gemm g{H, WinT + (size_t)l * E2 * DM};
                pg8::EpiBf16 E{UZ, E2};
                pg8::gemm_phase<pg8::EpiBf16, true, DM, DM, DM, 0, 32, 32>(lds, g, E, tid, G, bx);
            } else if (s == 1) {
                PHASE_ROOTS;
                if (!lru) {
                    for (int id = bx * 512 + tid; id < 256 * 512; id += G * 512) {
                        const int oc = id & 511, run = id >> 9, c = oc * 8, w = 2 << (oc >> 7), t0 = run * 32, pos0 = t0 & (SEQ - 1);
                        float s8[8];
#pragma unroll
                        for (int k = 0; k < 8; ++k) s8[k] = 0.f;
                        for (int d = 1; d <= w; ++d) if (pos0 - d >= 0) { float f[8]; unpack8(*(const u32x4*)(UZ + (size_t)(t0 - d) * E2 + c), f);
#pragma unroll
                            for (int k = 0; k < 8; ++k) s8[k] += f[k]; }
#pragma unroll 4
                        for (int i = 0; i < 32; ++i) { const int t = t0 + i, pos = pos0 + i; float f[8]; unpack8(*(const u32x4*)(UZ + (size_t)t * E2 + c), f);
#pragma unroll
                            for (int k = 0; k < 8; ++k) s8[k] += f[k];
                            if (pos >= w) { float o[8]; unpack8(*(const u32x4*)(UZ + (size_t)(t - w) * E2 + c), o);
#pragma unroll
                                for (int k = 0; k < 8; ++k) s8[k] -= o[k]; }
                            const float inv = 1.0f / (float)(pos + 1 < w ? pos + 1 : w); float d8[8];
#pragma unroll
                            for (int k = 0; k < 8; ++k) d8[k] = s8[k] * inv - f[k];
                            *(u32x4*)(Db + (size_t)t * EI + c) = pack8(d8); }
                    }
                } else {
                    const float* cw = a.in[I_CONVW] + (size_t)j * 4 * EI; const float* cb = a.in[I_CONVB] + (size_t)j * EI;
                    for (int id = bx * 512 + tid; id < 256 * 512; id += G * 512) {
                        const int oc = id & 511, run = id >> 9, c = oc * 8, t0 = run * 32, pos0 = t0 & (SEQ - 1);
                        float w0[8], w1[8], w2[8], w3[8], b8[8], u1[8], u2[8], u3[8];
#pragma unroll
                        for (int k = 0; k < 8; ++k) { w0[k] = cw[c + k]; w1[k] = cw[EI + c + k]; w2[k] = cw[2 * EI + c + k]; w3[k] = cw[3 * EI + c + k]; b8[k] = cb[c + k]; u1[k] = 0.f; u2[k] = 0.f; u3[k] = 0.f; }
                        if (pos0 > 0) { unpack8(*(const u32x4*)(UZ + (size_t)(t0 - 3) * E2 + c), u3); unpack8(*(const u32x4*)(UZ + (size_t)(t0 - 2) * E2 + c), u2); unpack8(*(const u32x4*)(UZ + (size_t)(t0 - 1) * E2 + c), u1); }
#pragma unroll 4
                        for (int i = 0; i < 32; ++i) { const int t = t0 + i; float f[8], o[8]; unpack8(*(const u32x4*)(UZ + (size_t)t * E2 + c), f);
#pragma unroll
                            for (int k = 0; k < 8; ++k) { o[k] = b8[k] + w0[k] * u3[k] + w1[k] * u2[k] + w2[k] * u1[k] + w3[k] * f[k]; u3[k] = u2[k]; u2[k] = u1[k]; u1[k] = f[k]; }
                            *(u32x4*)(Db + (size_t)t * EI + c) = pack8(o); }
                    }
                }
            } else if (s == 2) {
                PHASE_ROOTS;
                if (!lru) {
                    pg8::Gemm g{Db, PoolT + (size_t)j * EI * 1024};
                    pg8::EpiPool E{Y, UZ, a.in[I_POOLB] + (size_t)j * EI, a.in[I_POOLS] + (size_t)j * EI};
                    pg8::gemm_phase<pg8::EpiPool, true, EI, 1024, 1024, 4, 32, 16>(lds, g, E, tid, G, bx);
                } else {
                    pg8::Gemm g{Db, LruT + (size_t)j * E2 * 256};
                    pg8::EpiLru E{Db, LA, BT, a.in[I_BA] + (size_t)j * EI, a.in[I_BX] + (size_t)j * EI, NSP + (size_t)j * EI};
                    pg8::gemm_phase<pg8::EpiLru, true, EI, 256, 256, 2, 32, 32>(lds, g, E, tid, G, bx);
                }
            } else if (s == 3) {
                if (!lru) did = false;
                else { PHASE_ROOTS; for (int id = bx * 512 + tid; id < 256 * 512; id += G * 512) {
                    const int oc = id & 511, ch = id >> 9, c = oc * 8, t0 = ch * 32;
                    float hs[8], sl[8];
#pragma unroll
                    for (int k = 0; k < 8; ++k) { hs[k] = 0.f; sl[k] = 0.f; }
#pragma unroll 4
                    for (int i = 0; i < 32; ++i) { const size_t off = (size_t)(t0 + i) * EI + c; const u32x4 wl = *(const u32x4*)(LA + off); float b[8]; unpack8(*(const u32x4*)(BT + off), b);
                        const float l2[8] = {f16_lo(wl.x), f16_hi(wl.x), f16_lo(wl.y), f16_hi(wl.y), f16_lo(wl.z), f16_hi(wl.z), f16_lo(wl.w), f16_hi(wl.w)};
#pragma unroll
                        for (int k = 0; k < 8; ++k) { hs[k] = __builtin_amdgcn_exp2f(l2[k]) * hs[k] + b[k]; sl[k] += l2[k]; } }
                    float* pp = SP + (size_t)ch * EI + c; float* hp = SH + (size_t)ch * EI + c;
                    *(f32x4*)pp = (f32x4){sl[0], sl[1], sl[2], sl[3]}; *(f32x4*)(pp + 4) = (f32x4){sl[4], sl[5], sl[6], sl[7]};
                    *(f32x4*)hp = (f32x4){hs[0], hs[1], hs[2], hs[3]}; *(f32x4*)(hp + 4) = (f32x4){hs[4], hs[5], hs[6], hs[7]};
                } }
            } else if (s == 4) {
                if (!lru) did = false;
                else { PHASE_ROOTS; for (int id = bx * 512 + tid; id < 256 * 512; id += G * 512) {
                    const int oc = id & 511, ch = id >> 9, c = oc * 8, t0 = ch * 32, ch0 = ch & ~127;
                    float hs[8];
#pragma unroll
                    for (int k = 0; k < 8; ++k) hs[k] = 0.f;
#pragma unroll 4
                    for (int q = ch0; q < ch; ++q) { const float* pp = SP + (size_t)q * EI + c; const float* hp = SH + (size_t)q * EI + c;
                        const f32x4 p0 = *(const f32x4*)pp, p1 = *(const f32x4*)(pp + 4), h0 = *(const f32x4*)hp, h1 = *(const f32x4*)(hp + 4);
#pragma unroll
                        for (int k = 0; k < 4; ++k) { hs[k] = __builtin_amdgcn_exp2f(p0[k]) * hs[k] + h0[k]; hs[4 + k] = __builtin_amdgcn_exp2f(p1[k]) * hs[4 + k] + h1[k]; } }
#pragma unroll 4
                    for (int i = 0; i < 32; ++i) { const size_t off = (size_t)(t0 + i) * EI + c; const u32x4 wl = *(const u32x4*)(LA + off); float b[8], z[8], y[8];
                        unpack8(*(const u32x4*)(BT + off), b); unpack8(*(const u32x4*)(UZ + (size_t)(t0 + i) * E2 + EI + c), z);
                        const float l2[8] = {f16_lo(wl.x), f16_hi(wl.x), f16_lo(wl.y), f16_hi(wl.y), f16_lo(wl.z), f16_hi(wl.z), f16_lo(wl.w), f16_hi(wl.w)};
#pragma unroll
                        for (int k = 0; k < 8; ++k) { hs[k] = __builtin_amdgcn_exp2f(l2[k]) * hs[k] + b[k]; y[k] = hs[k] * z[k] * sigmoidf_fast(z[k]); }
                        *(u32x4*)(Y + off) = pack8(y); }
                } }
            } else if (s == 5) {
                PHASE_ROOTS;
                { pg8::Gemm g{Y, WoutT + (size_t)l * DM * EI};
                  pg8::EpiF32 E{O, DM}; pg8::gemm_phase<pg8::EpiF32, true, EI, EI, EI, 0, 32, 8>(lds, g, E, tid, G, bx); }
                { pg8::Gemm g{P16 + (size_t)l * M * PLE, WpleT + (size_t)l * DM * PLE};
                  pg8::EpiBf16 E{Eb, DM}; pg8::gemm_phase<pg8::EpiBf16, true, PLE, PLE, PLE, 0, 32, 8>(lds, g, E, tid, G, bx); }
            } else if (s == 6) {
                PHASE_ROOTS;
                const float* xin = (l == 0) ? a.in[I_X] : X;
                for (int m = gw; m < M; m += NGW) res_norm_row(xin + (size_t)m * DM, X + (size_t)m * DM, O + (size_t)m * DM, a.in[I_GPOST] + (size_t)l * DM, a.in[I_GPIN] + (size_t)l * DM, H + (size_t)m * DM, true, lane);
            } else if (s == 7) {
                PHASE_ROOTS;
                pg8::Gemm g{H, WgT + (size_t)l * DM * DM};
                pg8::EpiGate E{O, Eb}; pg8::gemm_phase<pg8::EpiGate, true, DM, DM, DM, 0, 32, 8>(lds, g, E, tid, G, bx);
            } else {
                PHASE_ROOTS;
                const int ln = (l + 1 < DEPTH) ? l + 1 : l;
                for (int m = gw; m < M; m += NGW) res_norm_row(X + (size_t)m * DM, X + (size_t)m * DM, O + (size_t)m * DM, a.in[I_GPOUT] + (size_t)l * DM, a.in[I_GPRE] + (size_t)ln * DM, H + (size_t)m * DM, l + 1 < DEPTH, lane);
            }
        }
        if (did && ph + 1 < ph_hi) { cg::this_grid().sync(); }
#undef a
    }
}


#if MK_DEBUG
__global__ void dbg_kernel(Args a, int ph) {
    unsigned char* ws = a.ws;
    bf16_t* H = (bf16_t*)(ws + WS_H); bf16_t* UZ = (bf16_t*)(ws + WS_UZ); bf16_t* Db = (bf16_t*)(ws + WS_D); bf16_t* Y = (bf16_t*)(ws + WS_Y);
    float* O = (float*)(ws + WS_O); bf16_t* Eb = (bf16_t*)(ws + WS_E); unsigned short* LA = (unsigned short*)(ws + WS_LA); bf16_t* BT = (bf16_t*)(ws + WS_BT);
    float* X = a.out;
        {
            unsigned* fw = (unsigned*)(ws + WS_DBG);
            if (ph == 0) { if (blockIdx.x == 0 && threadIdx.x == 0) *fw = 0xffffffffu; }
            else if (ph == NPHASE) { if (blockIdx.x == 0 && threadIdx.x == 0) { const unsigned f = *fw; if (f != 0xffffffffu) X[0] = 1000.0f * (float)f; } }
            if (ph >= 1 && ph < NPHASE && blockIdx.x == 0 && threadIdx.x < 64) {
                const int pl = (ph - 2 >= 0) ? (ph - 2) / 9 : -1, ps_ = (ph - 2 >= 0) ? (ph - 2) % 9 : -1;
                const int ln = threadIdx.x; const int pj = pl >> 1; const bool plru = (pl & 1) != 0;
                const int sm = (ln * 1237 + 5) % M;
                if (ph == 1) {
                    const int n = (ln * 389 + 7) % DM; const float* xr = a.in[I_X] + (size_t)sm * DM; float ss = 0.f; for (int k = 0; k < DM; ++k) ss += xr[k] * xr[k];
                    const float ref = xr[n] / sqrtf(ss / DM + RMS_EPS) * a.in[I_GPRE][n]; dbg_flag(fw, 1, dbf(H, (size_t)sm * DM + n), ref, 0.01f, 0.01f);
                } else if (pl <= 1) {
                    const int base = 10 + pl * 40;
                    if (ps_ == 0) { const int n = (ln * 4099 + 11) % E2; const float* W = a.in[I_WIN] + (size_t)pl * DM * E2; float acc = 0.f; for (int k = 0; k < DM; ++k) acc += dbf(H, (size_t)sm * DM + k) * W[(size_t)k * E2 + n];
                        dbg_flag(fw, base + 0, dbf(UZ, (size_t)sm * E2 + n), acc, 0.02f, 0.03f); }
                    else if (ps_ == 1) { const int t = (ln < 8) ? ln : (ln < 16 ? SEQ + (ln - 8) : (ln < 24 ? SEQ - 1 - (ln - 16) : sm)); const int c = (ln * 653 + 3) % EI; const int pos = t & (SEQ - 1);
                        if (!plru) { const int w = 2 << (c >> 10); float sum = 0.f; int cnt = 0; for (int d = 0; d < w; ++d) if (pos - d >= 0) { sum += dbf(UZ, (size_t)(t - d) * E2 + c); ++cnt; }
                            dbg_flag(fw, base + 1, dbf(Db, (size_t)t * EI + c), sum / cnt - dbf(UZ, (size_t)t * E2 + c), 0.02f, 0.02f); }
                        else { const float* cw = a.in[I_CONVW] + (size_t)pj * 4 * EI; float y = a.in[I_CONVB][(size_t)pj * EI + c]; for (int k = 0; k < 4; ++k) { const int tt = pos - 3 + k; if (tt >= 0) y += cw[k * EI + c] * dbf(UZ, (size_t)(t - 3 + k) * E2 + c); }
                            dbg_flag(fw, base + 2, dbf(Db, (size_t)t * EI + c), y, 0.02f, 0.02f); } }
                    else if (ps_ == 2) { const int c = (ln * 653 + 3) % EI;
                        if (!plru) { const int g = c >> 10, d = c & 1023; const float* W = a.in[I_POOLW] + ((size_t)(pj * 4 + g) << 20); float acc = 0.f; for (int k = 0; k < 1024; ++k) acc += dbf(Db, (size_t)sm * EI + g * 1024 + k) * W[(size_t)k * 1024 + d];
                            const float z = dbf(UZ, (size_t)sm * E2 + EI + c); const float ref = (acc + a.in[I_POOLB][(size_t)pj * EI + c]) * a.in[I_POOLS][(size_t)pj * EI + c] * z * dsig(z);
                            dbg_flag(fw, base + 3, dbf(Y, (size_t)sm * EI + c), ref, 0.03f, 0.03f); }
                        else { const int h = c >> 8, jn = c & 255; const float* Wa = a.in[I_WA] + ((size_t)(pj * 16 + h) << 16); const float* Wx = a.in[I_WX] + ((size_t)(pj * 16 + h) << 16); float ar = 0.f, ax = 0.f;
                            for (int k = 0; k < 256; ++k) { const float u = dbf(Db, (size_t)sm * EI + h * 256 + k); ar += u * Wa[k * 256 + jn]; ax += u * Wx[k * 256 + jn]; }
                            const float r = dsig(ar + a.in[I_BA][(size_t)pj * EI + c]), ig = dsig(ax + a.in[I_BX][(size_t)pj * EI + c]); const float lam = a.in[I_LAM][(size_t)pj * EI + c];
                            const float la = -8.0f * r * log1pf(expf(-lam)); const float mult = sqrtf(fmaxf(-expm1f(2.0f * la), 0.f)); const float bref = mult * ig * dbf(Db, (size_t)sm * EI + c);
                            dbg_flag(fw, base + 4, f16_lo((unsigned)LA[(size_t)sm * EI + c]), la * LOG2E, 0.02f, 0.002f); dbg_flag(fw, base + 5, dbf(BT, (size_t)sm * EI + c), bref, 0.03f, 0.01f); } }
                    else if (ps_ == 4 && plru) { const int c = (ln * 653 + 3) % EI; const int t = (ln < 8) ? ln * 40 : sm; const int tb = t & ~(SEQ - 1); float hh = 0.f;
                        for (int tt = tb; tt <= t; ++tt) hh = exp2f(f16_lo((unsigned)LA[(size_t)tt * EI + c])) * hh + dbf(BT, (size_t)tt * EI + c);
                        const float z = dbf(UZ, (size_t)t * E2 + EI + c); dbg_flag(fw, base + 6, dbf(Y, (size_t)t * EI + c), hh * z * dsig(z), 0.03f, 0.02f); }
                    else if (ps_ == 5) { const int n = (ln * 389 + 7) % DM; const float* W = a.in[I_WOUT] + (size_t)pl * EI * DM; float acc = 0.f; for (int k = 0; k < EI; ++k) acc += dbf(Y, (size_t)sm * EI + k) * W[(size_t)k * DM + n];
                        dbg_flag(fw, base + 7, O[(size_t)sm * DM + n], acc, 0.02f, 0.03f);
                        const float* Wp = a.in[I_WPLE] + (size_t)pl * PLE * DM; const float* pr = a.in[I_P] + ((size_t)pl * M + sm) * PLE; float e = 0.f; for (int k = 0; k < PLE; ++k) e += pr[k] * Wp[(size_t)k * DM + n];
                        dbg_flag(fw, base + 8, dbf(Eb, (size_t)sm * DM + n), e, 0.03f, 0.03f); }
                    else if (ps_ == 7) { const int n = (ln * 389 + 7) % DM; const float* W = a.in[I_WG] + (size_t)pl * DM * DM; float acc = 0.f; for (int k = 0; k < DM; ++k) acc += dbf(H, (size_t)sm * DM + k) * W[(size_t)k * DM + n];
                        dbg_flag(fw, base + 9, O[(size_t)sm * DM + n], dbf(Eb, (size_t)sm * DM + n) * dsig(acc), 0.03f, 0.03f); }
                }
            }
        }

}
#endif

extern "C" void kernel_launch(void* const* d_in, const int* in_sizes, int n_in, void* d_out, int out_size, void* d_ws, size_t ws_size, hipStream_t stream) {
    static int grid = 0;
    if (grid == 0) {
        if (n_in != 20 || out_size != M * DM || ws_size < WS_END) { fprintf(stderr, "kernel_launch: unexpected shapes (n_in %d out %d ws %zu)\n", n_in, out_size, ws_size); grid = -1; return; }
        int dev = 0, cus = 0, per_cu = 0;
        hipGetDevice(&dev); hipDeviceGetAttribute(&cus, hipDeviceAttributeMultiprocessorCount, dev);
        if (hipFuncSetAttribute((const void*)fwd_megakernel, hipFuncAttributeMaxDynamicSharedMemorySize, LDS_BYTES) != hipSuccess) { fprintf(stderr, "kernel_launch: hipFuncSetAttribute failed\n"); grid = -1; return; }
        if (hipOccupancyMaxActiveBlocksPerMultiprocessor(&per_cu, (const void*)fwd_megakernel, 512, LDS_BYTES) != hipSuccess || per_cu < 1) { fprintf(stderr, "kernel_launch: occupancy query gave %d\n", per_cu); per_cu = 1; }
        (void)hipGetLastError();
        grid = cus;
    }
    if (grid < 0) return;
    Args a{};
    for (int i = 0; i < 20; ++i) a.in[i] = (const float*)d_in[i];
    a.out = (float*)d_out; a.ws = (unsigned char*)d_ws;
#if MK_ONE_LAUNCH
    a.ph_lo = 0; a.ph_hi = NPHASE;
    void* args[] = {&a};
    hipError_t e = hipLaunchCooperativeKernel((const void*)fwd_megakernel, dim3(grid), dim3(512), args, LDS_BYTES, stream);
    if (e != hipSuccess) fprintf(stderr, "cooperative launch failed: %s (grid %d)\n", hipGetErrorString(e), grid);
#else
    for (int ph = 0; ph < NPHASE; ++ph) {
#if MK_DEBUG
        a.ph_lo = 0; a.ph_hi = 0;
        hipLaunchKernelGGL(dbg_kernel, dim3(1), dim3(64), 0, stream, a, ph);
#endif
        if (ph > 0 && ph < 1 + DEPTH * 9) { const int l = (ph - 1) / 9, s = (ph - 1) % 9; if (!(l & 1) && (s == 3 || s == 4)) continue; }
        a.ph_lo = ph; a.ph_hi = ph + 1;
        hipLaunchKernelGGL(fwd_megakernel, dim3(grid), dim3(512), LDS_BYTES, stream, a);
    }
#if MK_DEBUG
    hipLaunchKernelGGL(dbg_kernel, dim3(1), dim3(64), 0, stream, a, NPHASE);
#endif
#endif
}
```

```cpp
#include <hip/hip_runtime.h>
#include <hip/hip_cooperative_groups.h>
#include <cstdio>
#include <cstdint>
namespace cg = cooperative_groups;

#ifndef MK_ONE_LAUNCH
#define MK_ONE_LAUNCH 1
#endif

#define LAS __attribute__((address_space(3)))
typedef unsigned short bf16_t;
typedef short bf16x8 __attribute__((ext_vector_type(8)));
typedef float f32x4 __attribute__((ext_vector_type(4)));
typedef float f32x2 __attribute__((ext_vector_type(2)));
typedef unsigned u32x4 __attribute__((ext_vector_type(4)));
typedef unsigned u32x2 __attribute__((ext_vector_type(2)));
typedef _Float16 f16x2 __attribute__((ext_vector_type(2)));

constexpr int M = 8192, DM = 2048, EI = 4096, E2 = 8192, PLE = 256, SEQ = 4096, DEPTH = 4;
constexpr float RMS_EPS = 1e-6f;
constexpr float LOG2E = 1.4426950408889634f;

constexpr size_t MiB = 1u << 20;
constexpr size_t WS_WIN = 16 * MiB;
constexpr size_t WS_WOUT = 144 * MiB;
constexpr size_t WS_WG = 208 * MiB;
constexpr size_t WS_POOL = 240 * MiB;
constexpr size_t WS_WPLE = 256 * MiB;
constexpr size_t WS_LRU = 260 * MiB;
constexpr size_t WS_H = 272 * MiB;
constexpr size_t WS_UZ = 304 * MiB;
constexpr size_t WS_D = 432 * MiB;
constexpr size_t WS_Y = 496 * MiB;
constexpr size_t WS_O = 560 * MiB;
constexpr size_t WS_E = 624 * MiB;
constexpr size_t WS_LA = 656 * MiB;
constexpr size_t WS_BT = 720 * MiB;
constexpr size_t WS_SP = 784 * MiB;
constexpr size_t WS_SH = 788 * MiB;
constexpr size_t WS_P16 = 792 * MiB;
constexpr size_t WS_NSP = 808 * MiB;
constexpr size_t WS_DBG = 809 * MiB;
constexpr size_t WS_END = 810 * MiB;

constexpr size_t WS_CTL = 0, CTL_ZERO_BYTES = 65536;
constexpr int CW_BAR = 4096;
constexpr int LDS_BYTES = 147456;
constexpr int MISC_OFF = 131072 + 320;

__device__ __forceinline__ unsigned cvt_pk_bf16(float lo, float hi) { unsigned r; asm volatile("v_cvt_pk_bf16_f32 %0, %1, %2" : "=v"(r) : "v"(lo), "v"(hi)); return r; }
__device__ __forceinline__ float bf_lo(unsigned w) { return __uint_as_float(w << 16); }
__device__ __forceinline__ float bf_hi(unsigned w) { return __uint_as_float(w & 0xffff0000u); }
__device__ __forceinline__ unsigned pk_f16(float a, float b) { f16x2 h; h.x = (_Float16)a; h.y = (_Float16)b; return __builtin_bit_cast(unsigned, h); }
__device__ __forceinline__ float f16_lo(unsigned w) { f16x2 h = __builtin_bit_cast(f16x2, w); return (float)h.x; }
__device__ __forceinline__ float f16_hi(unsigned w) { f16x2 h = __builtin_bit_cast(f16x2, w); return (float)h.y; }
__device__ __forceinline__ float sigmoidf_fast(float v) { return __builtin_amdgcn_rcpf(1.0f + __builtin_amdgcn_exp2f(-v * LOG2E)); }
__device__ __forceinline__ float wave_sum(float v) {
#pragma unroll
    for (int o = 1; o < 64; o <<= 1) v += __shfl_xor(v, o);
    return v;
}


#define RLX_AGENT __ATOMIC_RELAXED, __HIP_MEMORY_SCOPE_AGENT
#define XB_TMO      128
#define XB_XCNT(j)  (256  + 64 * (j))
#define XB_XSUB(j)  (1280 + 64 * (j))
#define XB_XGEN(j)  (2304 + 64 * (j))
#define XB_TOP      3328
#define XB_TOPGEN   3392
#define XCD_BAR_WORDS 3456
#define XB_SPIN_CAP (1u << 18)

__device__ __forceinline__ unsigned xb_ld(unsigned* p)              { return __hip_atomic_load(p, __ATOMIC_RELAXED, __HIP_MEMORY_SCOPE_AGENT); }
__device__ __forceinline__ unsigned xb_add(unsigned* p, unsigned v) { return __hip_atomic_fetch_add(p, v, __ATOMIC_RELAXED, __HIP_MEMORY_SCOPE_AGENT); }
__device__ __forceinline__ unsigned xb_xcc_id() { return (unsigned)__builtin_amdgcn_s_getreg((3 << 11) | 20) & 0xFu; }
#define XB_SPIN(cond, bar) do { unsigned _sp = 0; while (cond) { __builtin_amdgcn_s_sleep(1); \
    if ((++_sp & 255u) == 0u) { if (xb_ld(&(bar)[XB_TMO])) break; if (_sp > XB_SPIN_CAP) { atomicAdd(&(bar)[XB_TMO], 1u); break; } } } } while (0)

struct XcdBarrier {
    unsigned* bar; unsigned x;
    volatile LAS unsigned* st;
};

__device__ __forceinline__ XcdBarrier xcd_barrier_post(unsigned* bar, volatile LAS unsigned* st) {
    XcdBarrier b; b.bar = bar; b.x = xb_xcc_id(); b.st = st;
    if (threadIdx.x == 0) (void)xb_add(&bar[XB_XCNT(b.x)], 1u);
    return b;
}
__device__ __forceinline__ void xcd_barrier_complete(unsigned* bar, unsigned x, unsigned& nloc, unsigned& nx) {
    const unsigned G = gridDim.x * gridDim.y * gridDim.z;
    unsigned sum, cnt, mine, sp = 0u;
    for (;;) {
        sum = 0u; cnt = 0u; mine = 0u;
#pragma unroll
        for (unsigned j = 0; j < 16; ++j) { const unsigned c = xb_ld(&bar[XB_XCNT(j)]); sum += c; cnt += (c > 0u) ? 1u : 0u; mine = (j == x) ? c : mine; }
        if (sum == G) break;
        __builtin_amdgcn_s_sleep(1);
        if ((++sp & 255u) == 0u) { if (xb_ld(&bar[XB_TMO])) break; if (sp > XB_SPIN_CAP) { atomicAdd(&bar[XB_TMO], 1u); break; } }
    }
    nloc = mine > 0u ? mine : 1u; nx = cnt > 0u ? cnt : 1u;
}

__device__ __forceinline__ void xcd_barrier(const XcdBarrier& b) {
    asm volatile("s_waitcnt vmcnt(0)" ::: "memory");
    __syncthreads();
    if (threadIdx.x == 0) {
        unsigned* bar = b.bar;
        __builtin_amdgcn_s_waitcnt(0);
        unsigned nloc = b.st[0], nx = b.st[1];
        if (nloc == 0u) { xcd_barrier_complete(bar, b.x, nloc, nx); b.st[0] = nloc; b.st[1] = nx; }
        const unsigned old = xb_add(&bar[XB_XSUB(b.x)], 1u);
        const unsigned gen = old / nloc;
        if (old + 1u == (gen + 1u) * nloc) {
            __builtin_amdgcn_fence(__ATOMIC_RELEASE, "agent");
            asm volatile("s_waitcnt vmcnt(0)" ::: "memory");
            const unsigned og = xb_add(&bar[XB_TOP], 1u);
            const unsigned tg = og / nx;
            if (og + 1u == (tg + 1u) * nx) xb_add(&bar[XB_TOPGEN], 1u);
            else XB_SPIN(xb_ld(&bar[XB_TOPGEN]) == tg, bar);
            __builtin_amdgcn_fence(__ATOMIC_ACQUIRE, "agent");
            xb_add(&bar[XB_XGEN(b.x)], 1u);
            asm volatile("s_waitcnt vmcnt(0)" ::: "memory");
        } else {
            XB_SPIN(xb_ld(&bar[XB_XGEN(b.x)]) == gen, bar);
            __builtin_amdgcn_fence(__ATOMIC_ACQUIRE, "agent");
            asm volatile("s_waitcnt vmcnt(0)" ::: "memory");
        }
    }
    __syncthreads();
}


namespace pg8 {
constexpr int BM = 256, BK = 64, HALF = 128, HTB = HALF * BK * 2, STAGE_BYTES = 8 * HTB, NXCD = 8, WGM = 8;
__host__ __device__ __forceinline__ int lds_byte(int r, int c) { const int st = (r >> 4) * 2 + (c >> 5), rr = r & 15, cc = c & 31, ob = rr * 64 + cc * 2; return st * 1024 + (ob ^ (((ob >> 9) & 1) << 5)); }
__host__ __device__ __forceinline__ void stage_rc(int b, int& R, int& C) { const int st = b / 1024, sb = b % 1024, swz = sb ^ (((sb >> 9) & 1) << 5); R = (st >> 1) * 16 + swz / 64; C = (st & 1) * 32 + (swz % 64) / 2; }
__host__ __device__ __forceinline__ int perm32(int rho) { const int n = rho >> 4, i = rho & 15; return 8 * (i >> 2) + 4 * n + (i & 3); }

struct Unit { int pm, pn; };
struct Gemm { const bf16_t* A; const bf16_t* Bt; };

template <int nM, int nN> struct StaticOrder {
    int G, c;
    static constexpr int nwg = nM * nN;
    __device__ __forceinline__ void init(int G_, int c_) { G = G_; c = c_; }
    __device__ __forceinline__ bool next(int i, Unit& u) const {
        const int L = i * G + c; if (L >= nwg) return false;
        int wgid = L; { constexpr int q = nwg / NXCD, r = nwg % NXCD; const int xcd = wgid % NXCD, off = wgid / NXCD; wgid = (xcd < r ? xcd * (q + 1) : r * (q + 1) + (xcd - r) * q) + off; }
        constexpr int nig = WGM * nN; const int gid = wgid / nig, fm = gid * WGM, gsz = (nM - fm) < WGM ? (nM - fm) : WGM;
        u.pm = fm + ((wgid % nig) % gsz); u.pn = (wgid % nig) / gsz; return true;
    }
};

struct EpiF32 {
    static constexpr bool PERM = false;
    float* C; int ldc;
    __device__ __forceinline__ void operator()(const f32x4 (&acc)[2][2][4][2], const Unit& u, int wr, int wc, int fr, int fq) const {
        const int row0 = u.pm * BM + wr * 64 + fr, col0 = u.pn * BM + wc * 32 + 4 * fq;
#pragma unroll
        for (int ai = 0; ai < 2; ++ai)
#pragma unroll
            for (int m = 0; m < 4; ++m) { float* rowp = C + (size_t)(row0 + ai * HALF + m * 16) * ldc + col0;
#pragma unroll
                for (int bj = 0; bj < 2; ++bj)
#pragma unroll
                    for (int n = 0; n < 2; ++n) *(f32x4*)(rowp + bj * HALF + n * 16) = acc[ai][bj][m][n]; }
    }
};
struct EpiBf16 {
    static constexpr bool PERM = true;
    bf16_t* O; int ldc;
    __device__ __forceinline__ void operator()(const f32x4 (&acc)[2][2][4][2], const Unit& u, int wr, int wc, int fr, int fq) const {
        const int row0 = u.pm * BM + wr * 64 + fr, col0 = u.pn * BM + wc * 32 + 8 * fq;
#pragma unroll
        for (int ai = 0; ai < 2; ++ai)
#pragma unroll
            for (int m = 0; m < 4; ++m) { bf16_t* rowp = O + (size_t)(row0 + ai * HALF + m * 16) * ldc + col0;
#pragma unroll
                for (int bj = 0; bj < 2; ++bj) { const f32x4 v0 = acc[ai][bj][m][0], v1 = acc[ai][bj][m][1];
                    u32x4 w; w.x = cvt_pk_bf16(v0[0], v0[1]); w.y = cvt_pk_bf16(v0[2], v0[3]); w.z = cvt_pk_bf16(v1[0], v1[1]); w.w = cvt_pk_bf16(v1[2], v1[3]);
                    *(u32x4*)(rowp + bj * HALF) = w; } }
    }
};
struct EpiPool {
    static constexpr bool PERM = true;
    bf16_t* Y; const bf16_t* UZ; const float* pb; const float* ps;
    __device__ __forceinline__ void operator()(const f32x4 (&acc)[2][2][4][2], const Unit& u, int wr, int wc, int fr, int fq) const {
        const int row0 = u.pm * BM + wr * 64 + fr, col0 = u.pn * BM + wc * 32 + 8 * fq;
#pragma unroll
        for (int bj = 0; bj < 2; ++bj) {
            const int c = col0 + bj * HALF;
            const f32x4 b0 = *(const f32x4*)(pb + c), b1 = *(const f32x4*)(pb + c + 4), s0 = *(const f32x4*)(ps + c), s1 = *(const f32x4*)(ps + c + 4);
#pragma unroll
            for (int ai = 0; ai < 2; ++ai)
#pragma unroll
                for (int m = 0; m < 4; ++m) { const size_t row = (size_t)(row0 + ai * HALF + m * 16);
                    const u32x4 zz = *(const u32x4*)(UZ + row * E2 + EI + c);
                    f32x4 v0 = (acc[ai][bj][m][0] + b0) * s0, v1 = (acc[ai][bj][m][1] + b1) * s1;
                    float z[8] = {bf_lo(zz.x), bf_hi(zz.x), bf_lo(zz.y), bf_hi(zz.y), bf_lo(zz.z), bf_hi(zz.z), bf_lo(zz.w), bf_hi(zz.w)};
#pragma unroll
                    for (int k = 0; k < 4; ++k) { v0[k] *= z[k] * sigmoidf_fast(z[k]); v1[k] *= z[4 + k] * sigmoidf_fast(z[4 + k]); }
                    u32x4 w; w.x = cvt_pk_bf16(v0[0], v0[1]); w.y = cvt_pk_bf16(v0[2], v0[3]); w.z = cvt_pk_bf16(v1[0], v1[1]); w.w = cvt_pk_bf16(v1[2], v1[3]);
                    *(u32x4*)(Y + row * EI + c) = w; }
        }
    }
};
struct EpiLru {
    static constexpr bool PERM = true;
    const bf16_t* UC; unsigned short* LA; bf16_t* BT; const float* ba; const float* bx; const float* lam;
    __device__ __forceinline__ void operator()(const f32x4 (&acc)[2][2][4][2], const Unit& u, int wr, int wc, int fr, int fq) const {
        const int row0 = u.pm * BM + wr * 64 + fr, c = (u.pn >> 1) * 256 + (u.pn & 1) * 128 + wc * 32 + 8 * fq;
        float cba[8], cbx[8], nsp[8];
#pragma unroll
        for (int k = 0; k < 8; ++k) { cba[k] = ba[c + k]; cbx[k] = bx[c + k]; nsp[k] = lam[c + k]; }
#pragma unroll
        for (int ai = 0; ai < 2; ++ai)
#pragma unroll
            for (int m = 0; m < 4; ++m) { const size_t off = (size_t)(row0 + ai * HALF + m * 16) * EI + c;
                const u32x4 uu = *(const u32x4*)(UC + off);
                const float ucv[8] = {bf_lo(uu.x), bf_hi(uu.x), bf_lo(uu.y), bf_hi(uu.y), bf_lo(uu.z), bf_hi(uu.z), bf_lo(uu.w), bf_hi(uu.w)};
                float l2[8], bb[8];
#pragma unroll
                for (int n = 0; n < 2; ++n)
#pragma unroll
                    for (int j = 0; j < 4; ++j) { const int k = 4 * n + j;
                        const float rg = sigmoidf_fast(acc[ai][0][m][n][j] + cba[k]), ig = sigmoidf_fast(acc[ai][1][m][n][j] + cbx[k]);
                        const float l2a = rg * nsp[k]; const float a2 = __builtin_amdgcn_exp2f(2.0f * l2a);
                        const float mult = __builtin_sqrtf(fmaxf(1.0f - a2, 0.f));
                        l2[k] = l2a; bb[k] = mult * ig * ucv[k]; }
                u32x4 wl, wb;
                wl.x = pk_f16(l2[0], l2[1]); wl.y = pk_f16(l2[2], l2[3]); wl.z = pk_f16(l2[4], l2[5]); wl.w = pk_f16(l2[6], l2[7]);
                wb.x = cvt_pk_bf16(bb[0], bb[1]); wb.y = cvt_pk_bf16(bb[2], bb[3]); wb.z = cvt_pk_bf16(bb[4], bb[5]); wb.w = cvt_pk_bf16(bb[6], bb[7]);
                *(u32x4*)(LA + off) = wl; *(u32x4*)(BT + off) = wb;
                asm volatile("" ::: "memory"); }
    }
};
struct EpiGate {
    static constexpr bool PERM = false;
    float* T; const bf16_t* Eb;
    __device__ __forceinline__ void operator()(const f32x4 (&acc)[2][2][4][2], const Unit& u, int wr, int wc, int fr, int fq) const {
        const int row0 = u.pm * BM + wr * 64 + fr, col0 = u.pn * BM + wc * 32 + 4 * fq;
#pragma unroll
        for (int ai = 0; ai < 2; ++ai)
#pragma unroll
            for (int m = 0; m < 4; ++m) { const size_t off = (size_t)(row0 + ai * HALF + m * 16) * DM + col0;
#pragma unroll
                for (int bj = 0; bj < 2; ++bj)
#pragma unroll
                    for (int n = 0; n < 2; ++n) { const u32x2 ee = *(const u32x2*)(Eb + off + bj * HALF + n * 16); const f32x4 a = acc[ai][bj][m][n];
                        f32x4 t; t[0] = bf_lo(ee.x) * sigmoidf_fast(a[0]); t[1] = bf_hi(ee.x) * sigmoidf_fast(a[1]); t[2] = bf_lo(ee.y) * sigmoidf_fast(a[2]); t[3] = bf_hi(ee.y) * sigmoidf_fast(a[3]);
                        *(f32x4*)(T + off + bj * HALF + n * 16) = t; } }
    }
};

template <class Epi, bool ALIGN_EPI, int LDA, int LDB, int K, int GRP, int NM, int NN>
__device__ __forceinline__ void gemm_phase(LAS unsigned char* lds, const Gemm g, const Epi& E, const int tid, const int G, const int bx) {
    StaticOrder<NM, NN> S; S.init(G, bx);
    const int wid = __builtin_amdgcn_readfirstlane(tid >> 6), lane = tid & 63, wr = wid >> 2, wc = wid & 3, fr = lane & 15, fq = lane >> 4;
    constexpr int nt = K / BK;
    unsigned voffA[2], voffB[2];
#pragma unroll
    for (int i = 0; i < 2; ++i) { int R, C; stage_rc(tid * 16 + i * 8192, R, C); const int Rb = Epi::PERM ? ((R & ~31) + perm32(R & 31)) : R;
        voffA[i] = (unsigned)(R * LDA + C) * 2u; voffB[i] = (unsigned)(Rb * LDB + C) * 2u; }
    constexpr size_t kstep = (size_t)(BK * 2);
    constexpr size_t hstepA = (size_t)HALF * LDA * 2, hstepB = (size_t)HALF * LDB * 2;
    const unsigned ldsw = (unsigned)wid * 1024u;
    const int aoff = lds_byte(wr * 64 + fr, fq * 8), boff = lds_byte(wc * 32 + fr, fq * 8);
#define PG8_UA(u) ((const char*)g.A + (size_t)(u).pm * 2 * hstepA + (GRP ? (size_t)((u).pn / (GRP ? GRP : 1)) * K * 2 : (size_t)0))
#define PG8_UB(u) ((const char*)g.Bt + (size_t)(u).pn * 2 * hstepB)
#define PG8_SA(b, h) (((b) * 2 + (h)) * HTB)
#define PG8_SB(b, h) ((4 + (b) * 2 + (h)) * HTB)
#define PG8_STAGE(bufoff, gbase, voff) do { _Pragma("unroll") for (int _i = 0; _i < 2; ++_i) \
        __builtin_amdgcn_global_load_lds((const unsigned*)((const char*)(gbase) + (voff)[_i]), (LAS unsigned*)(lds + (bufoff) + ldsw + _i * 8192), 16, 0, 0); } while (0)
#define PG8_LDA(dst, b, h) do { _Pragma("unroll") for (int m = 0; m < 4; ++m) _Pragma("unroll") for (int k = 0; k < 2; ++k) dst[m][k] = *(const LAS bf16x8*)(lds + PG8_SA(b, h) + aoff + m * 2048 + k * 1024); } while (0)
#define PG8_LDB(dst, b, h) do { _Pragma("unroll") for (int n = 0; n < 2; ++n) _Pragma("unroll") for (int k = 0; k < 2; ++k) dst[n][k] = *(const LAS bf16x8*)(lds + PG8_SB(b, h) + boff + n * 2048 + k * 1024); } while (0)
#define PG8_MMA(ai, bj, At, Bt) do { __builtin_amdgcn_s_setprio(1); _Pragma("unroll") for (int m = 0; m < 4; ++m) _Pragma("unroll") for (int n = 0; n < 2; ++n) _Pragma("unroll") for (int k = 0; k < 2; ++k) \
        acc[ai][bj][m][n] = __builtin_amdgcn_mfma_f32_16x16x32_bf16(Bt[n][k], At[m][k], acc[ai][bj][m][n], 0, 0, 0); __builtin_amdgcn_s_setprio(0); } while (0)
#define PG8_WAIT_V(n) asm volatile("s_waitcnt vmcnt(" #n ")" ::: "memory")
#define PG8_WAIT_L(n) asm volatile("s_waitcnt lgkmcnt(" #n ")" ::: "memory")
#define PG8_BAR __builtin_amdgcn_s_barrier()
#define PG8_SCHED __builtin_amdgcn_sched_barrier(0)
    Unit cur, nxt; int ui = 0;
    if (!S.next(0, cur)) return;
    f32x4 acc[2][2][4][2];
#pragma unroll
    for (int a = 0; a < 2; ++a)
#pragma unroll
        for (int b = 0; b < 2; ++b)
#pragma unroll
            for (int m = 0; m < 4; ++m)
#pragma unroll
                for (int n = 0; n < 2; ++n) acc[a][b][m][n] = (f32x4){0.f, 0.f, 0.f, 0.f};
    bf16x8 At[4][2], B0[2][2], B1[2][2];
    const char* cA = PG8_UA(cur); const char* cB = PG8_UB(cur);
    PG8_STAGE(PG8_SB(0, 0), cB, voffB); PG8_STAGE(PG8_SB(0, 1), cB + hstepB, voffB); PG8_STAGE(PG8_SA(0, 0), cA, voffA); PG8_STAGE(PG8_SA(0, 1), cA + hstepA, voffA);
    if (wr == 1) PG8_BAR;
    PG8_WAIT_V(2); PG8_BAR;
    PG8_STAGE(PG8_SB(1, 0), cB + kstep, voffB); PG8_STAGE(PG8_SA(1, 0), cA + kstep, voffA); PG8_STAGE(PG8_SB(1, 1), cB + hstepB + kstep, voffB);
    PG8_WAIT_V(6); PG8_BAR;
    for (;;) {
        const bool has_next = S.next(ui + 1, nxt);
        const char* nA = has_next ? PG8_UA(nxt) : cA; const char* nB = has_next ? PG8_UB(nxt) : cB;
#pragma nounroll
        for (int t = 0; t < nt; t += 2) {
            const bool last = (t == nt - 2);
            const char* a1 = cA + (size_t)(t + 1) * kstep;
            const char* a2 = last ? nA : cA + (size_t)(t + 2) * kstep; const char* b2 = last ? nB : cB + (size_t)(t + 2) * kstep;
            const char* a3 = a2 + kstep; const char* b3 = b2 + kstep;
            PG8_LDB(B0, 0, 0); PG8_LDB(B1, 0, 1); PG8_SCHED; PG8_LDA(At, 0, 0); PG8_STAGE(PG8_SA(1, 1), a1 + hstepA, voffA);
            PG8_WAIT_V(8); PG8_WAIT_L(0); PG8_BAR; PG8_MMA(0, 0, At, B0); PG8_MMA(0, 1, At, B1); PG8_BAR; PG8_SCHED;
            PG8_LDA(At, 0, 1); PG8_STAGE(PG8_SB(0, 0), b2, voffB); PG8_STAGE(PG8_SB(0, 1), b2 + hstepB, voffB); PG8_STAGE(PG8_SA(0, 0), a2, voffA);
            PG8_WAIT_V(8); PG8_WAIT_L(0); PG8_BAR; PG8_MMA(1, 0, At, B0); PG8_MMA(1, 1, At, B1); PG8_BAR; PG8_SCHED;
            PG8_LDB(B0, 1, 0); PG8_LDB(B1, 1, 1); PG8_SCHED; PG8_LDA(At, 1, 0); PG8_STAGE(PG8_SA(0, 1), a2 + hstepA, voffA);
            PG8_WAIT_V(8); PG8_WAIT_L(0); PG8_BAR; PG8_MMA(0, 0, At, B0); PG8_MMA(0, 1, At, B1); PG8_BAR; PG8_SCHED;
            PG8_LDA(At, 1, 1); PG8_STAGE(PG8_SB(1, 0), b3, voffB); PG8_STAGE(PG8_SB(1, 1), b3 + hstepB, voffB); PG8_STAGE(PG8_SA(1, 0), a3, voffA);
            PG8_WAIT_V(8); PG8_WAIT_L(0); PG8_BAR; PG8_MMA(1, 0, At, B0); PG8_MMA(1, 1, At, B1); PG8_BAR; PG8_SCHED;
        }
        if constexpr (ALIGN_EPI) { if (wr == 0) PG8_BAR; }
        E(acc, cur, wr, wc, fr, fq);
        if (!has_next) break;
#pragma unroll
        for (int a = 0; a < 2; ++a)
#pragma unroll
            for (int b = 0; b < 2; ++b)
#pragma unroll
                for (int m = 0; m < 4; ++m)
#pragma unroll
                    for (int n = 0; n < 2; ++n) acc[a][b][m][n] = (f32x4){0.f, 0.f, 0.f, 0.f};
        cur = nxt; cA = nA; cB = nB; ++ui;
        if constexpr (ALIGN_EPI) { if (wr == 1) PG8_BAR; }
    }
    PG8_WAIT_V(0);
    if constexpr (!ALIGN_EPI) { if (wr == 0) PG8_BAR; }
    PG8_BAR;
#undef PG8_UA
#undef PG8_UB
#undef PG8_SA
#undef PG8_SB
#undef PG8_STAGE
#undef PG8_LDA
#undef PG8_LDB
#undef PG8_MMA
#undef PG8_WAIT_V
#undef PG8_WAIT_L
#undef PG8_BAR
#undef PG8_SCHED
}
}

__device__ __forceinline__ void transpose_item(const float* W, int K, int N, bf16_t* WT, int drow0, int k0, int n0, LAS float* scr, int lane) {
    f32x4 v[8];
    const int lr = lane >> 3, lc = (lane & 7) * 4;
#pragma unroll
    for (int i = 0; i < 8; ++i) v[i] = *(const f32x4*)(W + (size_t)(k0 + 8 * i + lr) * N + n0 + lc);
#pragma unroll
    for (int i = 0; i < 8; ++i) { LAS float* s = scr + (8 * i + lr) * 33 + lc; s[0] = v[i][0]; s[1] = v[i][1]; s[2] = v[i][2]; s[3] = v[i][3]; }
    asm volatile("s_waitcnt lgkmcnt(0)" ::: "memory");
    const int c = lane & 7;
#pragma unroll
    for (int j = 0; j < 4; ++j) { const int n = (lane >> 3) + 8 * j; const LAS float* s = scr + (8 * c) * 33 + n;
        u32x4 o; o.x = cvt_pk_bf16(s[0 * 33], s[1 * 33]); o.y = cvt_pk_bf16(s[2 * 33], s[3 * 33]); o.z = cvt_pk_bf16(s[4 * 33], s[5 * 33]); o.w = cvt_pk_bf16(s[6 * 33], s[7 * 33]);
        *(u32x4*)(WT + (size_t)(drow0 + n) * K + k0 + 8 * c) = o; }
    asm volatile("s_waitcnt lgkmcnt(0)" ::: "memory");
}
__device__ __forceinline__ void transpose_plain(const float* W, int K, int N, bf16_t* WT, int it, LAS float* scr, int lane) {
    const int nblk = N / 32, kb = it / nblk, nb = it % nblk;
    transpose_item(W, K, N, WT, 32 * nb, 64 * kb, 32 * nb, scr, lane);
}
__device__ __forceinline__ void norm_row(const float* xrow, const float* g, bf16_t* hrow, int lane) {
    f32x4 v[8]; float ss = 0.f;
#pragma unroll
    for (int j = 0; j < 8; ++j) { v[j] = *(const f32x4*)(xrow + 4 * lane + 256 * j); ss += (v[j][0] * v[j][0] + v[j][1] * v[j][1]) + (v[j][2] * v[j][2] + v[j][3] * v[j][3]); }
    const float r = 1.0f / sqrtf(wave_sum(ss) * (1.0f / DM) + RMS_EPS);
#pragma unroll
    for (int j = 0; j < 8; ++j) { const f32x4 gg = *(const f32x4*)(g + 4 * lane + 256 * j); const f32x4 h = v[j] * r * gg;
        u32x2 w; w.x = cvt_pk_bf16(h[0], h[1]); w.y = cvt_pk_bf16(h[2], h[3]); *(u32x2*)(hrow + 4 * lane + 256 * j) = w; }
}
__device__ __forceinline__ void res_norm_row(const float* xin, float* xout, const float* o, const float* ga, const float* gb, bf16_t* hrow, bool write_h, int lane) {
    f32x4 v[8], x[8]; float ss = 0.f;
#pragma unroll
    for (int j = 0; j < 8; ++j) { v[j] = *(const f32x4*)(o + 4 * lane + 256 * j); x[j] = *(const f32x4*)(xin + 4 * lane + 256 * j); ss += (v[j][0] * v[j][0] + v[j][1] * v[j][1]) + (v[j][2] * v[j][2] + v[j][3] * v[j][3]); }
    const float r = 1.0f / sqrtf(wave_sum(ss) * (1.0f / DM) + RMS_EPS);
    float s2 = 0.f;
#pragma unroll
    for (int j = 0; j < 8; ++j) { const f32x4 gg = *(const f32x4*)(ga + 4 * lane + 256 * j); x[j] = x[j] + v[j] * r * gg; *(f32x4*)(xout + 4 * lane + 256 * j) = x[j];
        s2 += (x[j][0] * x[j][0] + x[j][1] * x[j][1]) + (x[j][2] * x[j][2] + x[j][3] * x[j][3]); }
    if (write_h) {
        const float r2 = 1.0f / sqrtf(wave_sum(s2) * (1.0f / DM) + RMS_EPS);
#pragma unroll
        for (int j = 0; j < 8; ++j) { const f32x4 gg = *(const f32x4*)(gb + 4 * lane + 256 * j); const f32x4 h = x[j] * r2 * gg;
            u32x2 w; w.x = cvt_pk_bf16(h[0], h[1]); w.y = cvt_pk_bf16(h[2], h[3]); *(u32x2*)(hrow + 4 * lane + 256 * j) = w; }
    }
}
__device__ __forceinline__ void unpack8(const u32x4 w, float (&f)[8]) { f[0] = bf_lo(w.x); f[1] = bf_hi(w.x); f[2] = bf_lo(w.y); f[3] = bf_hi(w.y); f[4] = bf_lo(w.z); f[5] = bf_hi(w.z); f[6] = bf_lo(w.w); f[7] = bf_hi(w.w); }
__device__ __forceinline__ u32x4 pack8(const float (&f)[8]) { u32x4 w; w.x = cvt_pk_bf16(f[0], f[1]); w.y = cvt_pk_bf16(f[2], f[3]); w.z = cvt_pk_bf16(f[4], f[5]); w.w = cvt_pk_bf16(f[6], f[7]); return w; }


#ifndef MK_DEBUG
#define MK_DEBUG 0
#endif
#if MK_DEBUG
__device__ __forceinline__ float dbf(const bf16_t* p, size_t i) { return __uint_as_float(((unsigned)p[i]) << 16); }
__device__ __forceinline__ float dsig(float v) { return 1.0f / (1.0f + expf(-v)); }
__device__ __forceinline__ void dbg_flag(unsigned* fw, int id, float got, float ref, float rtol, float atol) {
    const float err = fabsf(got - ref); if (!(err <= rtol * fabsf(ref) + atol)) atomicMin(fw, (unsigned)id);
}
#endif

struct Args { const float* in[20]; float* out; unsigned char* ws; int ph_lo, ph_hi; };
enum { I_X = 0, I_P, I_WIN, I_WOUT, I_GPRE, I_GPOST, I_POOLW, I_POOLB, I_POOLS, I_CONVW, I_CONVB, I_WA, I_BA, I_WX, I_BX, I_LAM, I_WPLE, I_WG, I_GPIN, I_GPOUT };
constexpr int NPHASE = 1 + DEPTH * 9;

__global__ void __launch_bounds__(512, 2) fwd_megakernel(Args a) {
    extern __shared__ __attribute__((aligned(16))) unsigned char lds_raw[];
    LAS unsigned char* lds = (LAS unsigned char*)lds_raw;
    const int G = gridDim.x;
    typedef const __attribute__((address_space(4))) Args* KArgs;
    KArgs ap = (KArgs)__builtin_amdgcn_kernarg_segment_ptr();
    const int ph_lo = ap->ph_lo, ph_hi = ap->ph_hi;
    for (int u = threadIdx.x; u < (LDS_BYTES - 131072) / 4; u += 512) ((LAS unsigned*)(lds + 131072))[u] = 0u;
    __syncthreads();
    XcdBarrier xbar = xcd_barrier_post((unsigned*)(ap->ws + WS_CTL) + CW_BAR, (volatile LAS unsigned*)(lds + MISC_OFF));

    for (int ph = ph_lo; ph < ph_hi; ++ph) {
        bool did = true;
        KArgs aq = ap; asm volatile("" : "+s"(aq));
#define a (*aq)
#define PHASE_ROOTS int tid = threadIdx.x, bx = blockIdx.x; asm volatile("" : "+v"(tid)); asm volatile("" : "+s"(bx)); __builtin_assume(tid >= 0 && tid < 512); __builtin_assume(bx >= 0 && bx < 1024); \
        const int lane = tid & 63, wave = __builtin_amdgcn_readfirstlane(tid >> 6); const int gw = bx * 8 + wave, NGW = G * 8; (void)lane; (void)gw; (void)NGW
        unsigned char* ws = a.ws;
        bf16_t* WinT = (bf16_t*)(ws + WS_WIN); bf16_t* WoutT = (bf16_t*)(ws + WS_WOUT); bf16_t* WgT = (bf16_t*)(ws + WS_WG); bf16_t* PoolT = (bf16_t*)(ws + WS_POOL);
        bf16_t* WpleT = (bf16_t*)(ws + WS_WPLE); bf16_t* LruT = (bf16_t*)(ws + WS_LRU);
        bf16_t* H = (bf16_t*)(ws + WS_H); bf16_t* UZ = (bf16_t*)(ws + WS_UZ); bf16_t* Db = (bf16_t*)(ws + WS_D); bf16_t* Y = (bf16_t*)(ws + WS_Y);
        float* O = (float*)(ws + WS_O); bf16_t* Eb = (bf16_t*)(ws + WS_E); unsigned short* LA = (unsigned short*)(ws + WS_LA); bf16_t* BT = (bf16_t*)(ws + WS_BT);
        float* SP = (float*)(ws + WS_SP); float* SH = (float*)(ws + WS_SH); bf16_t* P16 = (bf16_t*)(ws + WS_P16); float* NSP = (float*)(ws + WS_NSP);
        float* X = a.out;

        if (ph == 0) {
            PHASE_ROOTS;
            LAS float* scr = (LAS float*)(lds + wave * 16384);
            constexpr int N_WIN = 4 * 8192, N_WOUT = 4 * 4096, N_WG = 4 * 2048, N_POOL = 8 * 512, N_WPLE = 4 * 256, N_LRU = 64 * 32;
            constexpr int NITEMS = N_WIN + N_WOUT + N_WG + N_POOL + N_WPLE + N_LRU;
            for (int it = gw; it < NITEMS; it += NGW) {
                int r = it;
                if (r < N_WIN) { const int l = r / 8192; transpose_plain(a.in[I_WIN] + (size_t)l * DM * E2, DM, E2, WinT + (size_t)l * E2 * DM, r % 8192, scr, lane); continue; } r -= N_WIN;
                if (r < N_WOUT) { const int l = r / 4096; transpose_plain(a.in[I_WOUT] + (size_t)l * EI * DM, EI, DM, WoutT + (size_t)l * DM * EI, r % 4096, scr, lane); continue; } r -= N_WOUT;
                if (r < N_WG) { const int l = r / 2048; transpose_plain(a.in[I_WG] + (size_t)l * DM * DM, DM, DM, WgT + (size_t)l * DM * DM, r % 2048, scr, lane); continue; } r -= N_WG;
                if (r < N_POOL) { const int q = r / 512; transpose_plain(a.in[I_POOLW] + (size_t)q * 1024 * 1024, 1024, 1024, PoolT + (size_t)q * 1024 * 1024, r % 512, scr, lane); continue; } r -= N_POOL;
                if (r < N_WPLE) { const int l = r / 256; transpose_plain(a.in[I_WPLE] + (size_t)l * PLE * DM, PLE, DM, WpleT + (size_t)l * DM * PLE, r % 256, scr, lane); continue; } r -= N_WPLE;
                { const int q = r / 32, i2 = r % 32, which = q / 32, rem = q % 32, j = rem / 16, h = rem % 16, kb = i2 / 8, nb = i2 % 8, n0 = 32 * nb;
                  const float* src = (which ? a.in[I_WX] : a.in[I_WA]) + (size_t)rem * 65536;
                  const int drow0 = (2 * h + (n0 >> 7)) * 256 + which * 128 + (n0 & 127);
                  transpose_item(src, 256, 256, LruT + (size_t)j * E2 * 256, drow0, 64 * kb, n0, scr, lane); }
            }
            { const size_t n8 = (size_t)DEPTH * M * PLE / 8; const float* p = a.in[I_P];
              for (size_t i = (size_t)bx * 512 + tid; i < n8; i += (size_t)G * 512) { const f32x4 v0 = *(const f32x4*)(p + 8 * i), v1 = *(const f32x4*)(p + 8 * i + 4);
                  u32x4 w; w.x = cvt_pk_bf16(v0[0], v0[1]); w.y = cvt_pk_bf16(v0[2], v0[3]); w.z = cvt_pk_bf16(v1[0], v1[1]); w.w = cvt_pk_bf16(v1[2], v1[3]); *(u32x4*)(P16 + 8 * i) = w; } }
            for (int i = bx * 512 + tid; i < 2 * EI; i += G * 512) { const float nl = -a.in[I_LAM][i]; const float sp = fmaxf(nl, 0.f) + log1pf(expf(-fabsf(nl))); NSP[i] = -8.0f * LOG2E * sp; }
            for (int m = gw; m < M; m += NGW) norm_row(a.in[I_X] + (size_t)m * DM, a.in[I_GPRE], H + (size_t)m * DM, lane);
        } else if (ph < 1 + DEPTH * 9) {
            const int l = (ph - 1) / 9, s = (ph - 1) % 9; const bool lru = (l & 1) != 0; const int j = l >> 1;
            if (s == 0) {
                PHASE_ROOTS;
                pg8::Gemm g{H, WinT + (size_t)l * E2 * DM};
                pg8::EpiBf16 E{UZ, E2};
                pg8::gemm_phase<pg8::EpiBf16, true, DM, DM, DM, 0, 32, 32>(lds, g, E, tid, G, bx);
            } else if (s == 1) {
                PHASE_ROOTS;
                if (!lru) {
                    for (int id = bx * 512 + tid; id < 256 * 512; id += G * 512) {
                        const int oc = id & 511, run = id >> 9, c = oc * 8, w = 2 << (oc >> 7), t0 = run * 32, pos0 = t0 & (SEQ - 1);
                        float s8[8];
#pragma unroll
                        for (int k = 0; k < 8; ++k) s8[k] = 0.f;
                        for (int d = 1; d <= w; ++d) if (pos0 - d >= 0) { float f[8]; unpack8(*(const u32x4*)(UZ + (size_t)(t0 - d) * E2 + c), f);
#pragma unroll
                            for (int k = 0; k < 8; ++k) s8[k] += f[k]; }
#pragma unroll 4
                        for (int i = 0; i < 32; ++i) { const int t = t0 + i, pos = pos0 + i; float f[8]; unpack8(*(const u32x4*)(UZ + (size_t)t * E2 + c), f);
#pragma unroll
                            for (int k = 0; k < 8; ++k) s8[k] += f[k];
                            if (pos >= w) { float o[8]; unpack8(*(const u32x4*)(UZ + (size_t)(t - w) * E2 + c), o);
#pragma unroll
                                for (int k = 0; k < 8; ++k) s8[k] -= o[k]; }
                            const float inv = 1.0f / (float)(pos + 1 < w ? pos + 1 : w); float d8[8];
#pragma unroll
                            for (int k = 0; k < 8; ++k) d8[k] = s8[k] * inv - f[k];
                            *(u32x4*)(Db + (size_t)t * EI + c) = pack8(d8); }
                    }
                } else {
                    const float* cw = a.in[I_CONVW] + (size_t)j * 4 * EI; const float* cb = a.in[I_CONVB] + (size_t)j * EI;
                    for (int id = bx * 512 + tid; id < 256 * 512; id += G * 512) {
                        const int oc = id & 511, run = id >> 9, c = oc * 8, t0 = run * 32, pos0 = t0 & (SEQ - 1);
                        float w0[8], w1[8], w2[8], w3[8], b8[8], u1[8], u2[8], u3[8];
#pragma unroll
                        for (int k = 0; k < 8; ++k) { w0[k] = cw[c + k]; w1[k] = cw[EI + c + k]; w2[k] = cw[2 * EI + c + k]; w3[k] = cw[3 * EI + c + k]; b8[k] = cb[c + k]; u1[k] = 0.f; u2[k] = 0.f; u3[k] = 0.f; }
                        if (pos0 > 0) { unpack8(*(const u32x4*)(UZ + (size_t)(t0 - 3) * E2 + c), u3); unpack8(*(const u32x4*)(UZ + (size_t)(t0 - 2) * E2 + c), u2); unpack8(*(const u32x4*)(UZ + (size_t)(t0 - 1) * E2 + c), u1); }
#pragma unroll 4
                        for (int i = 0; i < 32; ++i) { const int t = t0 + i; float f[8], o[8]; unpack8(*(const u32x4*)(UZ + (size_t)t * E2 + c), f);
#pragma unroll
                            for (int k = 0; k < 8; ++k) { o[k] = b8[k] + w0[k] * u3[k] + w1[k] * u2[k] + w2[k] * u1[k] + w3[k] * f[k]; u3[k] = u2[k]; u2[k] = u1[k]; u1[k] = f[k]; }
                            *(u32x4*)(Db + (size_t)t * EI + c) = pack8(o); }
                    }
                }
            } else if (s == 2) {
                PHASE_ROOTS;
                if (!lru) {
                    pg8::Gemm g{Db, PoolT + (size_t)j * EI * 1024};
                    pg8::EpiPool E{Y, UZ, a.in[I_POOLB] + (size_t)j * EI, a.in[I_POOLS] + (size_t)j * EI};
                    pg8::gemm_phase<pg8::EpiPool, true, EI, 1024, 1024, 4, 32, 16>(lds, g, E, tid, G, bx);
                } else {
                    pg8::Gemm g{Db, LruT + (size_t)j * E2 * 256};
                    pg8::EpiLru E{Db, LA, BT, a.in[I_BA] + (size_t)j * EI, a.in[I_BX] + (size_t)j * EI, NSP + (size_t)j * EI};
                    pg8::gemm_phase<pg8::EpiLru, true, EI, 256, 256, 2, 32, 32>(lds, g, E, tid, G, bx);
                }
            } else if (s == 3) {
                if (!lru) did = false;
                else { PHASE_ROOTS; for (int id = bx * 512 + tid; id < 256 * 512; id += G * 512) {
                    const int oc = id & 511, ch = id >> 9, c = oc * 8, t0 = ch * 32;
                    float hs[8], sl[8];
#pragma unroll
                    for (int k = 0; k < 8; ++k) { hs[k] = 0.f; sl[k] = 0.f; }
#pragma unroll 4
                    for (int i = 0; i < 32; ++i) { const size_t off = (size_t)(t0 + i) * EI + c; const u32x4 wl = *(const u32x4*)(LA + off); float b[8]; unpack8(*(const u32x4*)(BT + off), b);
                        const float l2[8] = {f16_lo(wl.x), f16_hi(wl.x), f16_lo(wl.y), f16_hi(wl.y), f16_lo(wl.z), f16_hi(wl.z), f16_lo(wl.w), f16_hi(wl.w)};
#pragma unroll
                        for (int k = 0; k < 8; ++k) { hs[k] = __builtin_amdgcn_exp2f(l2[k]) * hs[k] + b[k]; sl[k] += l2[k]; } }
                    float* pp = SP + (size_t)ch * EI + c; float* hp = SH + (size_t)ch * EI + c;
                    *(f32x4*)pp = (f32x4){sl[0], sl[1], sl[2], sl[3]}; *(f32x4*)(pp + 4) = (f32x4){sl[4], sl[5], sl[6], sl[7]};
                    *(f32x4*)hp = (f32x4){hs[0], hs[1], hs[2], hs[3]}; *(f32x4*)(hp + 4) = (f32x4){hs[4], hs[5], hs[6], hs[7]};
                } }
            } else if (s == 4) {
                if (!lru) did = false;
                else { PHASE_ROOTS; for (int id = bx * 512 + tid; id < 256 * 512; id += G * 512) {
                    const int oc = id & 511, ch = id >> 9, c = oc * 8, t0 = ch * 32, ch0 = ch & ~127;
                    float hs[8];
#pragma unroll
                    for (int k = 0; k < 8; ++k) hs[k] = 0.f;
#pragma unroll 4
                    for (int q = ch0; q < ch; ++q) { const float* pp = SP + (size_t)q * EI + c; const float* hp = SH + (size_t)q * EI + c;
                        const f32x4 p0 = *(const f32x4*)pp, p1 = *(const f32x4*)(pp + 4), h0 = *(const f32x4*)hp, h1 = *(const f32x4*)(hp + 4);
#pragma unroll
                        for (int k = 0; k < 4; ++k) { hs[k] = __builtin_amdgcn_exp2f(p0[k]) * hs[k] + h0[k]; hs[4 + k] = __builtin_amdgcn_exp2f(p1[k]) * hs[4 + k] + h1[k]; } }
#pragma unroll 4
                    for (int i = 0; i < 32; ++i) { const size_t off = (size_t)(t0 + i) * EI + c; const u32x4 wl = *(const u32x4*)(LA + off); float b[8], z[8], y[8];
                        unpack8(*(const u32x4*)(BT + off), b); unpack8(*(const u32x4*)(UZ + (size_t)(t0 + i) * E2 + EI + c), z);
                        const float l2[8] = {f16_lo(wl.x), f16_hi(wl.x), f16_lo(wl.y), f16_hi(wl.y), f16_lo(wl.z), f16_hi(wl.z), f16_lo(wl.w), f16_hi(wl.w)};
#pragma unroll
                        for (int k = 0; k < 8; ++k) { hs[k] = __builtin_amdgcn_exp2f(l2[k]) * hs[k] + b[k]; y[k] = hs[k] * z[k] * sigmoidf_fast(z[k]); }
                        *(u32x4*)(Y + off) = pack8(y); }
                } }
            } else if (s == 5) {
                PHASE_ROOTS;
                { pg8::Gemm g{Y, WoutT + (size_t)l * DM * EI};
                  pg8::EpiF32 E{O, DM}; pg8::gemm_phase<pg8::EpiF32, true, EI, EI, EI, 0, 32, 8>(lds, g, E, tid, G, bx); }
                { pg8::Gemm g{P16 + (size_t)l * M * PLE, WpleT + (size_t)l * DM * PLE};
                  pg8::EpiBf16 E{Eb, DM}; pg8::gemm_phase<pg8::EpiBf16, true, PLE, PLE, PLE, 0, 32, 8>(lds, g, E, tid, G, bx); }
            } else if (s == 6) {
                PHASE_ROOTS;
                const float* xin = (l == 0) ? a.in[I_X] : X;
                for (int m = gw; m < M; m += NGW) res_norm_row(xin + (size_t)m * DM, X + (size_t)m * DM, O + (size_t)m * DM, a.in[I_GPOST] + (size_t)l * DM, a.in[I_GPIN] + (size_t)l * DM, H + (size_t)m * DM, true, lane);
            } else if (s == 7) {
                PHASE_ROOTS;
                pg8::Gemm g{H, WgT + (size_t)l * DM * DM};
                pg8::EpiGate E{O, Eb}; pg8::gemm_phase<pg8::EpiGate, true, DM, DM, DM, 0, 32, 8>(lds, g, E, tid, G, bx);
            } else {
                PHASE_ROOTS;
                const int ln = (l + 1 < DEPTH) ? l + 1 : l;
                for (int m = gw; m < M; m += NGW) res_norm_row(X + (size_t)m * DM, X + (size_t)m * DM, O + (size_t)m * DM, a.in[I_GPOUT] + (size_t)l * DM, a.in[I_GPRE] + (size_t)ln * DM, H + (size_t)m * DM, l + 1 < DEPTH, lane);
            }
        }
        if (did && ph + 1 < ph_hi) { if (ph == 0) cg::this_grid().sync(); else xcd_barrier(xbar); }
#undef a
    }
}


#if MK_DEBUG
__global__ void dbg_kernel(Args a, int ph) {
    unsigned char* ws = a.ws;
    bf16_t* H = (bf16_t*)(ws + WS_H); bf16_t* UZ = (bf16_t*)(ws + WS_UZ); bf16_t* Db = (bf16_t*)(ws + WS_D); bf16_t* Y = (bf16_t*)(ws + WS_Y);
    float* O = (float*)(ws + WS_O); bf16_t* Eb = (bf16_t*)(ws + WS_E); unsigned short* LA = (unsigned short*)(ws + WS_LA); bf16_t* BT = (bf16_t*)(ws + WS_BT);
    float* X = a.out;
        {
            unsigned* fw = (unsigned*)(ws + WS_DBG);
            if (ph == 0) { if (blockIdx.x == 0 && threadIdx.x == 0) *fw = 0xffffffffu; }
            else if (ph == NPHASE) { if (blockIdx.x == 0 && threadIdx.x == 0) { const unsigned f = *fw; if (f != 0xffffffffu) X[0] = 1000.0f * (float)f; } }
            if (ph >= 1 && ph < NPHASE && blockIdx.x == 0 && threadIdx.x < 64) {
                const int pl = (ph - 2 >= 0) ? (ph - 2) / 9 : -1, ps_ = (ph - 2 >= 0) ? (ph - 2) % 9 : -1;
                const int ln = threadIdx.x; const int pj = pl >> 1; const bool plru = (pl & 1) != 0;
                const int sm = (ln * 1237 + 5) % M;
                if (ph == 1) {
                    const int n = (ln * 389 + 7) % DM; const float* xr = a.in[I_X] + (size_t)sm * DM; float ss = 0.f; for (int k = 0; k < DM; ++k) ss += xr[k] * xr[k];
                    const float ref = xr[n] / sqrtf(ss / DM + RMS_EPS) * a.in[I_GPRE][n]; dbg_flag(fw, 1, dbf(H, (size_t)sm * DM + n), ref, 0.01f, 0.01f);
                } else if (pl <= 1) {
                    const int base = 10 + pl * 40;
                    if (ps_ == 0) { const int n = (ln * 4099 + 11) % E2; const float* W = a.in[I_WIN] + (size_t)pl * DM * E2; float acc = 0.f; for (int k = 0; k < DM; ++k) acc += dbf(H, (size_t)sm * DM + k) * W[(size_t)k * E2 + n];
                        dbg_flag(fw, base + 0, dbf(UZ, (size_t)sm * E2 + n), acc, 0.02f, 0.03f); }
                    else if (ps_ == 1) { const int t = (ln < 8) ? ln : (ln < 16 ? SEQ + (ln - 8) : (ln < 24 ? SEQ - 1 - (ln - 16) : sm)); const int c = (ln * 653 + 3) % EI; const int pos = t & (SEQ - 1);
                        if (!plru) { const int w = 2 << (c >> 10); float sum = 0.f; int cnt = 0; for (int d = 0; d < w; ++d) if (pos - d >= 0) { sum += dbf(UZ, (size_t)(t - d) * E2 + c); ++cnt; }
                            dbg_flag(fw, base + 1, dbf(Db, (size_t)t * EI + c), sum / cnt - dbf(UZ, (size_t)t * E2 + c), 0.02f, 0.02f); }
                        else { const float* cw = a.in[I_CONVW] + (size_t)pj * 4 * EI; float y = a.in[I_CONVB][(size_t)pj * EI + c]; for (int k = 0; k < 4; ++k) { const int tt = pos - 3 + k; if (tt >= 0) y += cw[k * EI + c] * dbf(UZ, (size_t)(t - 3 + k) * E2 + c); }
                            dbg_flag(fw, base + 2, dbf(Db, (size_t)t * EI + c), y, 0.02f, 0.02f); } }
                    else if (ps_ == 2) { const int c = (ln * 653 + 3) % EI;
                        if (!plru) { const int g = c >> 10, d = c & 1023; const float* W = a.in[I_POOLW] + ((size_t)(pj * 4 + g) << 20); float acc = 0.f; for (int k = 0; k < 1024; ++k) acc += dbf(Db, (size_t)sm * EI + g * 1024 + k) * W[(size_t)k * 1024 + d];
                            const float z = dbf(UZ, (size_t)sm * E2 + EI + c); const float ref = (acc + a.in[I_POOLB][(size_t)pj * EI + c]) * a.in[I_POOLS][(size_t)pj * EI + c] * z * dsig(z);
                            dbg_flag(fw, base + 3, dbf(Y, (size_t)sm * EI + c), ref, 0.03f, 0.03f); }
                        else { const int h = c >> 8, jn = c & 255; const float* Wa = a.in[I_WA] + ((size_t)(pj * 16 + h) << 16); const float* Wx = a.in[I_WX] + ((size_t)(pj * 16 + h) << 16); float ar = 0.f, ax = 0.f;
                            for (int k = 0; k < 256; ++k) { const float u = dbf(Db, (size_t)sm * EI + h * 256 + k); ar += u * Wa[k * 256 + jn]; ax += u * Wx[k * 256 + jn]; }
                            const float r = dsig(ar + a.in[I_BA][(size_t)pj * EI + c]), ig = dsig(ax + a.in[I_BX][(size_t)pj * EI + c]); const float lam = a.in[I_LAM][(size_t)pj * EI + c];
                            const float la = -8.0f * r * log1pf(expf(-lam)); const float mult = sqrtf(fmaxf(-expm1f(2.0f * la), 0.f)); const float bref = mult * ig * dbf(Db, (size_t)sm * EI + c);
                            dbg_flag(fw, base + 4, f16_lo((unsigned)LA[(size_t)sm * EI + c]), la * LOG2E, 0.02f, 0.002f); dbg_flag(fw, base + 5, dbf(BT, (size_t)sm * EI + c), bref, 0.03f, 0.01f); } }
                    else if (ps_ == 4 && plru) { const int c = (ln * 653 + 3) % EI; const int t = (ln < 8) ? ln * 40 : sm; const int tb = t & ~(SEQ - 1); float hh = 0.f;
                        for (int tt = tb; tt <= t; ++tt) hh = exp2f(f16_lo((unsigned)LA[(size_t)tt * EI + c])) * hh + dbf(BT, (size_t)tt * EI + c);
                        const float z = dbf(UZ, (size_t)t * E2 + EI + c); dbg_flag(fw, base + 6, dbf(Y, (size_t)t * EI + c), hh * z * dsig(z), 0.03f, 0.02f); }
                    else if (ps_ == 5) { const int n = (ln * 389 + 7) % DM; const float* W = a.in[I_WOUT] + (size_t)pl * EI * DM; float acc = 0.f; for (int k = 0; k < EI; ++k) acc += dbf(Y, (size_t)sm * EI + k) * W[(size_t)k * DM + n];
                        dbg_flag(fw, base + 7, O[(size_t)sm * DM + n], acc, 0.02f, 0.03f);
                        const float* Wp = a.in[I_WPLE] + (size_t)pl * PLE * DM; const float* pr = a.in[I_P] + ((size_t)pl * M + sm) * PLE; float e = 0.f; for (int k = 0; k < PLE; ++k) e += pr[k] * Wp[(size_t)k * DM + n];
                        dbg_flag(fw, base + 8, dbf(Eb, (size_t)sm * DM + n), e, 0.03f, 0.03f); }
                    else if (ps_ == 7) { const int n = (ln * 389 + 7) % DM; const float* W = a.in[I_WG] + (size_t)pl * DM * DM; float acc = 0.f; for (int k = 0; k < DM; ++k) acc += dbf(H, (size_t)sm * DM + k) * W[(size_t)k * DM + n];
                        dbg_flag(fw, base + 9, O[(size_t)sm * DM + n], dbf(Eb, (size_t)sm * DM + n) * dsig(acc), 0.03f, 0.03f); }
                }
            }
        }

}
#endif

extern "C" void kernel_launch(void* const* d_in, const int* in_sizes, int n_in, void* d_out, int out_size, void* d_ws, size_t ws_size, hipStream_t stream) {
    static int grid = 0;
    if (grid == 0) {
        if (n_in != 20 || out_size != M * DM || ws_size < WS_END) { fprintf(stderr, "kernel_launch: unexpected shapes (n_in %d out %d ws %zu)\n", n_in, out_size, ws_size); grid = -1; return; }
        int dev = 0, cus = 0, per_cu = 0;
        hipGetDevice(&dev); hipDeviceGetAttribute(&cus, hipDeviceAttributeMultiprocessorCount, dev);
        if (hipFuncSetAttribute((const void*)fwd_megakernel, hipFuncAttributeMaxDynamicSharedMemorySize, LDS_BYTES) != hipSuccess) { fprintf(stderr, "kernel_launch: hipFuncSetAttribute failed\n"); grid = -1; return; }
        if (hipOccupancyMaxActiveBlocksPerMultiprocessor(&per_cu, (const void*)fwd_megakernel, 512, LDS_BYTES) != hipSuccess || per_cu < 1) { fprintf(stderr, "kernel_launch: occupancy query gave %d\n", per_cu); per_cu = 1; }
        (void)hipGetLastError();
        grid = cus;
    }
    if (grid < 0) return;
    if (hipMemsetAsync((char*)d_ws + WS_CTL, 0, CTL_ZERO_BYTES, stream) != hipSuccess) { fprintf(stderr, "kernel_launch: memset failed\n"); return; }
    Args a{};
    for (int i = 0; i < 20; ++i) a.in[i] = (const float*)d_in[i];
    a.out = (float*)d_out; a.ws = (unsigned char*)d_ws;
#if MK_ONE_LAUNCH
    a.ph_lo = 0; a.ph_hi = NPHASE;
    void* args[] = {&a};
    hipError_t e = hipLaunchCooperativeKernel((const void*)fwd_megakernel, dim3(grid), dim3(512), args, LDS_BYTES, stream);
    if (e != hipSuccess) fprintf(stderr, "cooperative launch failed: %s (grid %d)\n", hipGetErrorString(e), grid);
#else
    for (int ph = 0; ph < NPHASE; ++ph) {
#if MK_DEBUG
        a.ph_lo = 0; a.ph_hi = 0;
        hipLaunchKernelGGL(dbg_kernel, dim3(1), dim3(64), 0, stream, a, ph);
#endif
        if (ph > 0 && ph < 1 + DEPTH * 9) { const int l = (ph - 1) / 9, s = (ph - 1) % 9; if (!(l & 1) && (s == 3 || s == 4)) continue; }
        a.ph_lo = ph; a.ph_hi = ph + 1;
        hipLaunchKernelGGL(fwd_megakernel, dim3(grid), dim3(512), LDS_BYTES, stream, a);
    }
#if MK_DEBUG
    hipLaunchKernelGGL(dbg_kernel, dim3(1), dim3(64), 0, stream, a, NPHASE);
#endif
#endif
}
```
